# Optimizing an MI355X kernel written in HIP

```python
import math
import jax
import jax.numpy as jnp
from jax import lax
import numpy as np

D_MODEL = 1024
BATCH = 16
SEQ = 4096
DEPTH = 4
DEC_BATCH = 4
DEC_SEQ = 4096
PAST_LEN = 128

HEAD_DIM = 64
MIX_WIDTH = D_MODEL // 2
N_EVEN = (DEPTH + 1) // 2
N_ODD = DEPTH // 2
NORM_EPS = 1e-6
NEG_INF = -1e30

GRID_W = 64
NA_HEADS = MIX_WIDTH // HEAD_DIM
NA_KH = 8
NA_KW = 16

HGRN_HEADS = 4
HGRN_DK = MIX_WIDTH // HGRN_HEADS
HGRN_DV = MIX_WIDTH // HGRN_HEADS
HGRN_CHUNK = 64

RG_BLOCKS = 8
RG_BW = MIX_WIDTH // RG_BLOCKS
RG_C = 8.0
CONV_W = 4
CONV_PAD = (CONV_W // 2, CONV_W - 1 - CONV_W // 2)

DIL_HEADS = MIX_WIDTH // HEAD_DIM
DIL_PAIRS = ((128, 1), (512, 4), (2048, 16))
DIL_HALF = DIL_PAIRS[0][0] // (2 * DIL_PAIRS[0][1])
T5_BUCKETS = 32
T5_MAX_DIST = 1024

D_FF = -(-(8 * D_MODEL) // (3 * 256)) * 256
EVEN_IN = 8 * MIX_WIDTH
ODD_IN = 5 * MIX_WIDTH

kernel_name = 'hybrid_bidir_encoder_na_hgrn2_rglru_dilated'


def _rms_norm(x, g):
    xf = x.astype(jnp.float32)
    y = xf * lax.rsqrt(jnp.mean(xf * xf, axis=-1, keepdims=True) + NORM_EPS)
    return (y * g.astype(jnp.float32)).astype(x.dtype)


def _swiglu(h, w_gate, w_up, w_down):
    return (jax.nn.silu(h @ w_gate) * (h @ w_up)) @ w_down


def _neighbourhood_attention(q, k, v, rpb):
    B, S, H, hd = q.shape
    rows = S // GRID_W
    kh = min(NA_KH, rows)
    r = jnp.arange(rows)
    c = jnp.arange(GRID_W)
    key_rows = jnp.clip(r - kh // 2, 0, rows - kh)[:, None] + jnp.arange(kh)[None, :]
    col_start = jnp.clip(c - NA_KW // 2, 0, GRID_W - NA_KW)
    col_ok = (c[None, :] >= col_start[:, None]) & (c[None, :] < col_start[:, None] + NA_KW)
    dr_idx = key_rows - r[:, None] + (NA_KH - 1)
    dc_idx = jnp.clip(c[None, :] - c[:, None] + (NA_KW - 1), 0, 2 * NA_KW - 2)
    bias = rpb.astype(jnp.float32)[:, dr_idx[:, :, None, None], dc_idx[None, None, :, :]]
    bias = bias.transpose(1, 0, 3, 2, 4)

    def grid(t):
        return t.reshape(B, rows, GRID_W, H, hd)

    kg = grid(k)[:, key_rows]
    vg = grid(v)[:, key_rows]
    s = jnp.einsum('brqhd,brkwhd->brhqkw', grid(q), kg).astype(jnp.float32) + bias
    s = jnp.where(col_ok[:, None, :], s, NEG_INF)
    p = jax.nn.softmax(s.reshape(B, rows, H, GRID_W, kh * GRID_W), axis=-1).reshape(s.shape)
    o = jnp.einsum('brhqkw,brkwhd->brqhd', p, vg.astype(jnp.float32))
    return o.reshape(B, S, H, hd)


def _hgrn2_scan(q, k, v, log_f):
    B, S, H, DK = q.shape
    DV = v.shape[-1]
    nc = S // HGRN_CHUNK

    def chunks(t):
        return t.reshape(B, nc, HGRN_CHUNK, H, t.shape[-1]).transpose(1, 0, 3, 2, 4)

    lower = jnp.tril(jnp.ones((HGRN_CHUNK, HGRN_CHUNK), dtype=bool))

    def step(state, inp):
        qc, kc, vc, gc = inp
        b = jnp.cumsum(gc, axis=2)
        diff = jnp.where(lower[:, :, None], b[:, :, :, None, :] - b[:, :, None, :, :], -jnp.inf)
        attn = jnp.einsum('bhtd,bhsd,bhtsd->bhts', qc, kc, jnp.exp(diff))
        o = jnp.einsum('bhts,bhsv->bhtv', attn, vc) + jnp.einsum('bhtd,bhdv->bhtv', qc * jnp.exp(b), state)
        b_last = b[:, :, -1:, :]
        state = jnp.exp(b_last[:, :, 0, :, None]) * state + jnp.einsum('bhsd,bhsv->bhdv', kc * jnp.exp(b_last - b), vc)
        return state, o

    s0 = jnp.zeros((B, H, DK, DV), jnp.float32)
    _, o = lax.scan(step, s0, (chunks(q), chunks(k), chunks(v), chunks(log_f)))
    return o.transpose(1, 0, 3, 2, 4).reshape(B, S, H, DV)


def _hgrn2(q, f_fwd, f_bwd, i, g, lb, onorm_g):
    B, S, _ = q.shape

    def heads(t):
        return t.astype(jnp.float32).reshape(B, S, HGRN_HEADS, -1)

    qh = jax.nn.silu(heads(q))
    vh = heads(i)
    lbh = lb.reshape(2, HGRN_HEADS, HGRN_DK)
    o = jnp.zeros((B, S, HGRN_HEADS, HGRN_DV), jnp.float32)
    for d, fz in enumerate((f_fwd, f_bwd)):
        z = heads(fz)
        log_f = jnp.logaddexp(jnp.log(lbh[d]), jnp.log1p(-lbh[d]) + jax.nn.log_sigmoid(z))
        kk = (1.0 - lbh[d]) * jax.nn.sigmoid(-z)
        args = (qh, kk, vh, log_f)
        if d == 1:
            args = tuple(jnp.flip(t, 1) for t in args)
        od = _hgrn2_scan(*args)
        o = o + (jnp.flip(od, 1) if d == 1 else od)
    o = o * lax.rsqrt(jnp.mean(o * o, axis=-1, keepdims=True) + NORM_EPS) * onorm_g.astype(jnp.float32)
    o = o * jax.nn.silu(heads(g))
    return o.reshape(B, S, MIX_WIDTH)


def _lin_combine(left, right):
    a_l, u_l = left
    a_r, u_r = right
    return a_l * a_r, a_r * u_l + u_r


def _rglru(y, w_a, b_a, w_x, b_x, lam, reverse):
    B, S, W = y.shape
    yf = y.astype(jnp.float32)
    yb = yf.reshape(B, S, RG_BLOCKS, RG_BW)

    def block_linear(w, b):
        return jnp.einsum('bsnc,ncd->bsnd', yb, w.astype(jnp.float32)).reshape(B, S, W) + b.astype(jnp.float32)

    r = jax.nn.sigmoid(block_linear(w_a, b_a))
    i = jax.nn.sigmoid(block_linear(w_x, b_x))
    log_a = -RG_C * r * jax.nn.softplus(-lam.astype(jnp.float32))
    scale = jnp.sqrt(-jnp.expm1(2.0 * log_a))
    first = S - 1 if reverse else 0
    scale = jnp.where((jnp.arange(S) == first)[None, :, None], 1.0, scale)
    _, h = lax.associative_scan(_lin_combine, (jnp.exp(log_a), scale * i * yf), axis=1, reverse=reverse)
    return h


def _t5_bucket(rel):
    half = T5_BUCKETS // 2
    exact = half // 2
    n = jnp.abs(rel)
    large = exact + (jnp.log(jnp.maximum(n, 1).astype(jnp.float32) / exact)
                     / math.log(T5_MAX_DIST / exact) * (half - exact)).astype(jnp.int32)
    large = jnp.minimum(large, half - 1)
    return jnp.where(rel > 0, half, 0) + jnp.where(n < exact, n, large)


def _dilated_branch(q, k, v, t5_bias, dil):
    B, S, H, hd = q.shape
    L = S // dil
    nb = -(-L // DIL_HALF)
    lp = nb * DIL_HALF
    bd = B * dil

    def to_sub(t):
        return t.reshape(B, L, dil, H, hd).transpose(0, 2, 1, 3, 4).reshape(bd, L, H, hd)

    qs = jnp.pad(to_sub(q), ((0, 0), (0, lp - L), (0, 0), (0, 0))).reshape(bd, nb, DIL_HALF, H, hd)

    def key_windows(t):
        tp = jnp.pad(to_sub(t), ((0, 0), (DIL_HALF, lp - L + DIL_HALF), (0, 0), (0, 0)))
        tp = tp.reshape(bd, nb + 2, DIL_HALF, H, hd)
        return jnp.concatenate([tp[:, :-2], tp[:, 1:-1], tp[:, 2:]], axis=2)

    kw = key_windows(k)
    vw = key_windows(v)
    qi = jnp.arange(DIL_HALF)
    ki = jnp.arange(3 * DIL_HALF)
    rel = ki[None, :] - DIL_HALF - qi[:, None]
    key_idx = jnp.arange(nb)[:, None] * DIL_HALF + ki[None, :] - DIL_HALF
    valid = ((key_idx >= 0) & (key_idx < L))[:, None, :] & (jnp.abs(rel) <= DIL_HALF)[None]
    bias = t5_bias.astype(jnp.float32)[_t5_bucket(rel * dil)].transpose(2, 0, 1)
    s = jnp.einsum('nbqhd,nbkhd->nbhqk', qs, kw).astype(jnp.float32) + bias
    s = jnp.where(valid[None, :, None], s, NEG_INF)
    m = jnp.max(s, axis=-1, keepdims=True)
    p = jnp.exp(s - m)
    den = jnp.sum(p, axis=-1)
    out = jnp.einsum('nbhqk,nbkhd->nbqhd', p, vw.astype(jnp.float32)) / den.transpose(0, 1, 3, 2)[..., None]
    lse = (m[..., 0] + jnp.log(den)).transpose(0, 1, 3, 2)
    out = out.reshape(bd, lp, H, hd)[:, :L].reshape(B, dil, L, H, hd).transpose(0, 2, 1, 3, 4).reshape(B, S, H, hd)
    lse = lse.reshape(bd, lp, H)[:, :L].reshape(B, dil, L, H).transpose(0, 2, 1, 3).reshape(B, S, H)
    return out, lse


def _dilated_attention(q, k, v, t5_bias):
    outs = []
    lses = []
    for _, dil in DIL_PAIRS:
        o, l = _dilated_branch(q, k, v, t5_bias, dil)
        outs.append(o)
        lses.append(l)
    wts = jax.nn.softmax(jnp.stack(lses), axis=0)
    return jnp.einsum('gbsh,gbshd->bshd', wts, jnp.stack(outs))


def _even_mixer(h, w_in, w_out, rpb, lb, onorm_g):
    B, S, _ = h.shape
    z = h @ w_in
    qa, ka, va, qb, fb_f, fb_b, ib, gb = jnp.split(z, 8, axis=-1)

    def heads(t):
        return t.reshape(B, S, NA_HEADS, HEAD_DIM)

    oa = _neighbourhood_attention(heads(qa) * HEAD_DIM ** -0.5, heads(ka), heads(va), rpb)
    ob = _hgrn2(qb, fb_f, fb_b, ib, gb, lb, onorm_g)
    mixed = jnp.concatenate([oa.reshape(B, S, MIX_WIDTH), ob], axis=-1).astype(h.dtype)
    return mixed @ w_out


def _odd_mixer(h, w_in, w_out, conv_w, conv_b, wa, ba, wx, bx, lam, t5_bias):
    B, S, _ = h.shape
    z = h @ w_in
    gc, xc, qd, kd, vd = jnp.split(z, 5, axis=-1)
    y = lax.conv_general_dilated(xc, conv_w[:, None, :], window_strides=(1,), padding=[CONV_PAD],
                                 dimension_numbers=('NWC', 'WIO', 'NWC'),
                                 feature_group_count=MIX_WIDTH) + conv_b
    hc = _rglru(y, wa[0], ba[0], wx[0], bx[0], lam[0], False) + _rglru(y, wa[1], ba[1], wx[1], bx[1], lam[1], True)
    oc = hc * jax.nn.gelu(gc.astype(jnp.float32))

    def heads(t):
        return t.reshape(B, S, DIL_HEADS, HEAD_DIM)

    od = _dilated_attention(heads(qd) * HEAD_DIM ** -0.5, heads(kd), heads(vd), t5_bias)
    mixed = jnp.concatenate([oc, od.reshape(B, S, MIX_WIDTH)], axis=-1).astype(h.dtype)
    return mixed @ w_out


def setup_inputs(seed: int = 0) -> dict:
    key = jax.random.key(seed)
    ks = jax.random.split(key, 22)

    def normal(k, shape, scale):
        return jax.random.normal(k, shape, jnp.float32) * scale

    a_pow = jax.random.uniform(ks[16], (N_ODD, 2, MIX_WIDTH), jnp.float32, 0.9, 0.999)
    a_base = a_pow ** (1.0 / RG_C)
    return {
        'x_prompt': normal(ks[0], (BATCH, SEQ, D_MODEL), 1.0),
        'x_sample': normal(ks[1], (DEC_BATCH, DEC_SEQ, D_MODEL), 1.0),
        'norm_g': 1.0 + normal(ks[2], (DEPTH, 4, D_MODEL), 0.02),
        'w_in_even': normal(ks[3], (N_EVEN, D_MODEL, EVEN_IN), D_MODEL ** -0.5),
        'w_out_even': normal(ks[4], (N_EVEN, 2 * MIX_WIDTH, D_MODEL), (2 * MIX_WIDTH) ** -0.5),
        'na_rpb': normal(ks[5], (N_EVEN, NA_HEADS, 2 * NA_KH - 1, 2 * NA_KW - 1), 0.1),
        'hgrn_lb': normal(ks[6], (N_EVEN, 2, MIX_WIDTH), 1.0),
        'hgrn_onorm': 1.0 + normal(ks[7], (N_EVEN, HGRN_DV), 0.02),
        'w_in_odd': normal(ks[8], (N_ODD, D_MODEL, ODD_IN), D_MODEL ** -0.5),
        'w_out_odd': normal(ks[9], (N_ODD, 2 * MIX_WIDTH, D_MODEL), (2 * MIX_WIDTH) ** -0.5),
        'conv_w': normal(ks[10], (N_ODD, CONV_W, MIX_WIDTH), CONV_W ** -0.5),
        'conv_b': normal(ks[11], (N_ODD, MIX_WIDTH), 0.01),
        'rg_wa': normal(ks[12], (N_ODD, 2, RG_BLOCKS, RG_BW, RG_BW), RG_BW ** -0.5),
        'rg_ba': normal(ks[13], (N_ODD, 2, MIX_WIDTH), 0.01),
        'rg_wx': normal(ks[14], (N_ODD, 2, RG_BLOCKS, RG_BW, RG_BW), RG_BW ** -0.5),
        'rg_bx': normal(ks[15], (N_ODD, 2, MIX_WIDTH), 0.01),
        'rg_lambda': jnp.log(a_base) - jnp.log1p(-a_base),
        't5_bias': normal(ks[17], (T5_BUCKETS, DIL_HEADS), 0.1),
        'w_gate': normal(ks[18], (DEPTH, D_MODEL, D_FF), D_MODEL ** -0.5),
        'w_up': normal(ks[19], (DEPTH, D_MODEL, D_FF), D_MODEL ** -0.5),
        'w_down': normal(ks[20], (DEPTH, D_FF, D_MODEL), D_FF ** -0.5),
    }


def reference(x_prompt, x_sample, norm_g, w_in_even, w_out_even, na_rpb, hgrn_lb, hgrn_onorm,
              w_in_odd, w_out_odd, conv_w, conv_b, rg_wa, rg_ba, rg_wx, rg_bx, rg_lambda,
              t5_bias, w_gate, w_up, w_down):
    lb_all = jnp.cumsum(jax.nn.softmax(hgrn_lb.astype(jnp.float32), axis=0), axis=0)
    lb_all = lb_all - lb_all[0:1]

    def trunk(x):
        for layer in range(DEPTH):
            idx = layer // 2
            h = _rms_norm(x, norm_g[layer, 0])
            if layer % 2 == 0:
                mix = _even_mixer(h, w_in_even[idx], w_out_even[idx], na_rpb[idx], lb_all[idx], hgrn_onorm[idx])
            else:
                mix = _odd_mixer(h, w_in_odd[idx], w_out_odd[idx], conv_w[idx], conv_b[idx], rg_wa[idx],
                                 rg_ba[idx], rg_wx[idx], rg_bx[idx], rg_lambda[idx], t5_bias)
            x = x + _rms_norm(mix, norm_g[layer, 1])
            h = _rms_norm(x, norm_g[layer, 2])
            x = x + _rms_norm(_swiglu(h, w_gate[layer], w_up[layer], w_down[layer]), norm_g[layer, 3])
        return x

    y_prompt = trunk(x_prompt)
    y_sample = trunk(x_sample)
    return (y_prompt, y_sample)
```

```cpp
#include <hip/hip_runtime.h>
#include <hip/hip_cooperative_groups.h>
#include <cstdio>
namespace cg = cooperative_groups;

#ifndef DBG_SKIP
#define DBG_SKIP 0
#endif
#ifndef DBG_REP
#define DBG_REP 0
#endif
#ifndef MK_MULTI_LAUNCH
#define MK_MULTI_LAUNCH 0
#endif

#define LAS __attribute__((address_space(3)))
typedef unsigned short bf16_t;
typedef short bf16x8 __attribute__((ext_vector_type(8)));
typedef short bf16x4 __attribute__((ext_vector_type(4)));
typedef float f32x4 __attribute__((ext_vector_type(4)));
typedef unsigned u32x4 __attribute__((ext_vector_type(4)));
typedef unsigned u32x2 __attribute__((ext_vector_type(2)));
typedef unsigned short us2_t __attribute__((ext_vector_type(2)));

constexpr int DM = 1024, SEQ = 4096, NSEQ = 20, NTOK = NSEQ * SEQ, MIXW = 512, DFF = 2816;
constexpr int ZLD_E = 4096, ZLD_O = 2560;
constexpr int NTHR = 512;
constexpr int LDS_BYTES = 156 * 1024;

constexpr size_t LW_WIN = 0, LW_WOUT = (size_t)4096 * 1024 * 2, LW_WGU = LW_WOUT + (size_t)1024 * 1024 * 2,
                 LW_WD = LW_WGU + (size_t)5632 * 1024 * 2, LW_STRIDE = LW_WD + (size_t)1024 * 2816 * 2;
constexpr size_t WS_CTL = 0, CTL_BYTES = 32768, WS_W = CTL_BYTES, WS_RGW = WS_W + 4 * LW_STRIDE, WS_RGS = WS_RGW + (size_t)2 * 131072 * 2;
constexpr size_t RGS_ONE = (size_t)NSEQ * 64 * 2 * 512 * 4;
constexpr size_t WS_HB = WS_RGS + 3 * RGS_ONE, WS_HGB = WS_HB + (size_t)NTOK * 1024 * 2, WS_BIG = WS_HGB + (size_t)NTOK * 512 * 2,
                 WS_END = WS_BIG + (size_t)NTOK * 4096 * 2;
constexpr size_t BIG_Y = (size_t)NTOK * DFF * 2;
constexpr size_t WS_RS = WS_END;
static_assert(WS_RS + (size_t)NTOK * 4 <= (size_t)1073741824, "workspace");
static_assert(BIG_Y + (size_t)NTOK * 1024 * 2 <= (size_t)NTOK * 4096 * 2, "Y fits");

struct Params {
    const float* in[21];
    float* out;
    unsigned char* ws;
    int ph_lo, ph_hi;
};

__device__ __forceinline__ float bf2f(bf16_t b) { return __uint_as_float(((unsigned)b) << 16); }
typedef __bf16 bf16v2_t __attribute__((ext_vector_type(2)));
typedef float f32x2 __attribute__((ext_vector_type(2)));
__device__ __forceinline__ unsigned cvt_pk_bf16(float lo, float hi) { const f32x2 v = {lo, hi}; const bf16v2_t b = __builtin_convertvector(v, bf16v2_t); return __builtin_bit_cast(unsigned, b); }
__device__ __forceinline__ bf16_t f2bf(float f) { return (bf16_t)(cvt_pk_bf16(f, 0.f) & 0xffffu); }
__device__ __forceinline__ bf16x8 pack8(f32x4 a, f32x4 b) {
    u32x4 w; w.x = cvt_pk_bf16(a[0], a[1]); w.y = cvt_pk_bf16(a[2], a[3]); w.z = cvt_pk_bf16(b[0], b[1]); w.w = cvt_pk_bf16(b[2], b[3]);
    return __builtin_bit_cast(bf16x8, w);
}
__device__ __forceinline__ f32x4 mfma16(bf16x8 a, bf16x8 b, f32x4 c) { return __builtin_amdgcn_mfma_f32_16x16x32_bf16(a, b, c, 0, 0, 0); }
#define WAVE_SYNC() asm volatile("s_waitcnt lgkmcnt(0)" ::: "memory")
__device__ __forceinline__ float fexp(float x) { return __builtin_amdgcn_exp2f(x * 1.44269504f); }
__device__ __forceinline__ float flog(float x) { return __builtin_amdgcn_logf(x) * 0.69314718f; }
__device__ __forceinline__ float sigmoidf_(float x) { return __builtin_amdgcn_rcpf(1.0f + fexp(-x)); }
__device__ __forceinline__ float siluf_(float x) { return x * sigmoidf_(x); }
__device__ __forceinline__ float wave_sum(float v) {
#pragma unroll
    for (int o = 32; o > 0; o >>= 1) v += __shfl_xor(v, o);
    return v;
}

__device__ __forceinline__ int TID() { int t = threadIdx.x; asm volatile("" : "+v"(t)); return t; }
__device__ __forceinline__ int BID() { int t = blockIdx.x; asm volatile("" : "+s"(t)); return t; }
__device__ __forceinline__ int GDIM() { int t = gridDim.x; asm volatile("" : "+s"(t)); return t; }

__constant__ unsigned char T5_BUCKET[3 * 129] = {
11,11,11,11,11,11,11,11,11,11,11,11,11,11,11,10,10,10,10,10,10,10,10,10,10,10,10,10,10,10,10,10,10,10,10,10,10,10,9,9,9,9,9,9,9,9,9,9,9,9,8,8,8,8,8,8,8,7,6,5,4,3,2,1,0,17,18,19,20,21,22,23,24,24,24,24,24,24,24,25,25,25,25,25,25,25,25,25,25,25,25,26,26,26,26,26,26,26,26,26,26,26,26,26,26,26,26,26,26,26,26,26,26,26,27,27,27,27,27,27,27,27,27,27,27,27,27,27,27,
13,13,13,13,13,13,13,13,13,13,13,13,13,13,13,13,13,13,13,13,13,13,13,12,12,12,12,12,12,12,12,12,12,12,12,12,12,12,12,12,12,12,11,11,11,11,11,11,11,11,11,11,10,10,10,10,10,10,9,9,9,8,8,4,0,20,24,24,25,25,25,26,26,26,26,26,26,27,27,27,27,27,27,27,27,27,27,28,28,28,28,28,28,28,28,28,28,28,28,28,28,28,28,28,28,28,29,29,29,29,29,29,29,29,29,29,29,29,29,29,29,29,29,29,29,29,29,29,29,
15,15,15,15,15,15,15,15,15,15,15,15,15,15,15,15,15,15,15,15,15,15,15,15,15,15,15,15,15,15,14,14,14,14,14,14,14,14,14,14,14,14,14,14,14,13,13,13,13,13,13,13,13,13,12,12,12,12,12,11,11,10,10,9,0,25,26,26,27,27,28,28,28,28,28,29,29,29,29,29,29,29,29,29,30,30,30,30,30,30,30,30,30,30,30,30,30,30,30,31,31,31,31,31,31,31,31,31,31,31,31,31,31,31,31,31,31,31,31,31,31,31,31,31,31,31,31,31,31};

namespace pg8 {
constexpr int BM = 256, BK = 64, HALF = 128, HTB = HALF * BK * 2, STAGE_BYTES = 8 * HTB, NXCD = 8, WGM = 8;
__device__ __forceinline__ int lds_byte(int r, int c) { const int st = (r >> 4) * 2 + (c >> 5), rr = r & 15, cc = c & 31, ob = rr * 64 + cc * 2; return st * 1024 + (ob ^ (((ob >> 9) & 1) << 5)); }
__device__ __forceinline__ void stage_rc(int b, int& R, int& C) { const int st = b / 1024, sb = b % 1024, swz = sb ^ (((sb >> 9) & 1) << 5); R = (st >> 1) * 16 + swz / 64; C = (st & 1) * 32 + (swz % 64) / 2; }
__device__ __forceinline__ int perm32(int rho) { const int n = rho >> 4, i = rho & 15; return 8 * (i >> 2) + 4 * n + (i & 3); }
struct Unit { int pm, pn; };
struct Gemm { const bf16_t* A; const bf16_t* Bt; int M, N, K; };
struct StaticOrder {
    int nM, nN, nwg, G, c;
    __device__ __forceinline__ void init(int M, int N, int G_, int c_) { nM = M / BM; nN = N / BM; nwg = nM * nN; G = G_; c = c_; }
    __device__ bool next(int i, Unit& u) const {
        const long L = (long)i * G + c; if (L >= nwg) return false;
        int wgid = (int)L; { const int q = nwg / NXCD, r = nwg % NXCD, xcd = wgid % NXCD, off = wgid / NXCD; wgid = (xcd < r ? xcd * (q + 1) : r * (q + 1) + (xcd - r) * q) + off; }
        const int nig = WGM * nN, gid = wgid / nig, fm = gid * WGM, gsz = (nM - fm) < WGM ? (nM - fm) : WGM;
        u.pm = fm + ((wgid % nig) % gsz); u.pn = (wgid % nig) / gsz; return true;
    }
};
struct EpiStore {
    bf16_t* O; int ldc; const float* rs;
    __device__ __forceinline__ void operator()(const f32x4 (&acc)[2][2][4][2], const Unit& u, int wr, int wc, int fr, int fq) const {
        const int row0 = u.pm * BM + wr * 64 + fr; const int col0 = u.pn * BM + wc * 32 + 8 * fq;
#pragma unroll
        for (int ai = 0; ai < 2; ++ai)
#pragma unroll
            for (int m = 0; m < 4; ++m) { const int row = row0 + ai * HALF + m * 16; bf16_t* rowp = O + (size_t)row * ldc + col0; const float sc = rs ? rs[row] : 1.0f;
#pragma unroll
                for (int bj = 0; bj < 2; ++bj) { const f32x4 v0 = acc[ai][bj][m][0] * sc, v1 = acc[ai][bj][m][1] * sc;
                    u32x4 w; w.x = cvt_pk_bf16(v0[0], v0[1]); w.y = cvt_pk_bf16(v0[2], v0[3]); w.z = cvt_pk_bf16(v1[0], v1[1]); w.w = cvt_pk_bf16(v1[2], v1[3]);
                    *(u32x4*)(rowp + bj * HALF) = w; } }
    }
};
struct EpiSwiGLU {
    bf16_t* O; int ldc; const float* rs;
    __device__ __forceinline__ void operator()(const f32x4 (&acc)[2][2][4][2], const Unit& u, int wr, int wc, int fr, int fq) const {
        const int row0 = u.pm * BM + wr * 64 + fr; const int col0 = u.pn * HALF + wc * 32 + 8 * fq;
#pragma unroll
        for (int ai = 0; ai < 2; ++ai)
#pragma unroll
            for (int m = 0; m < 4; ++m) { const int row = row0 + ai * HALF + m * 16; bf16_t* rowp = O + (size_t)row * ldc + col0; const float sc = rs[row];
                f32x4 v0, v1;
#pragma unroll
                for (int j = 0; j < 4; ++j) { v0[j] = siluf_(acc[ai][0][m][0][j] * sc) * (acc[ai][1][m][0][j] * sc); v1[j] = siluf_(acc[ai][0][m][1][j] * sc) * (acc[ai][1][m][1][j] * sc); }
                u32x4 w; w.x = cvt_pk_bf16(v0[0], v0[1]); w.y = cvt_pk_bf16(v0[2], v0[3]); w.z = cvt_pk_bf16(v1[0], v1[1]); w.w = cvt_pk_bf16(v1[2], v1[3]);
                *(u32x4*)rowp = w; }
    }
};

template <class Epi>
__device__ __forceinline__ void gemm_phase(LAS unsigned char* lds, const Gemm g, const StaticOrder& S, const Epi& E) {
    const int tid = TID(), wid = __builtin_amdgcn_readfirstlane(tid >> 6), lane = tid & 63, wr = wid >> 2, wc = wid & 3, fr = lane & 15, fq = lane >> 4;
    const int K = g.K, nt = K / BK;
    unsigned voffA[2], voffB[2];
#pragma unroll
    for (int i = 0; i < 2; ++i) { int R, C; stage_rc(tid * 16 + i * 8192, R, C); const int Rb = (R & ~31) + perm32(R & 31);
        voffA[i] = (unsigned)(R * K + C) * 2u; voffB[i] = (unsigned)(Rb * K + C) * 2u; }
    const size_t kstep = (size_t)(BK * 2);
    const size_t hstep = (size_t)HALF * K * 2;
    const size_t tstep = 2 * hstep;
    const unsigned ldsw = (unsigned)wid * 1024u;
    const int aoff = lds_byte(wr * 64 + fr, fq * 8), boff = lds_byte(wc * 32 + fr, fq * 8);
#define PG8_SA(b, h) (((b) * 2 + (h)) * HTB)
#define PG8_SB(b, h) ((4 + (b) * 2 + (h)) * HTB)
#define PG8_STAGE(bufoff, gbase, voff) do { _Pragma("unroll") for (int _i = 0; _i < 2; ++_i) \
        __builtin_amdgcn_global_load_lds((const unsigned*)((const char*)(gbase) + (voff)[_i]), (LAS unsigned*)(lds + (bufoff) + ldsw + _i * 8192), 16, 0, 0); } while (0)
#define PG8_LDA(dst, b, h) do { _Pragma("unroll") for (int m = 0; m < 4; ++m) _Pragma("unroll") for (int k = 0; k < 2; ++k) dst[m][k] = *(const LAS bf16x8*)(lds + PG8_SA(b, h) + aoff + m * 2048 + k * 1024); } while (0)
#define PG8_LDB(dst, b, h) do { _Pragma("unroll") for (int n = 0; n < 2; ++n) _Pragma("unroll") for (int k = 0; k < 2; ++k) dst[n][k] = *(const LAS bf16x8*)(lds + PG8_SB(b, h) + boff + n * 2048 + k * 1024); } while (0)
#define PG8_MMA(ai, bj, At, Bt) do { __builtin_amdgcn_s_setprio(1); _Pragma("unroll") for (int m = 0; m < 4; ++m) _Pragma("unroll") for (int n = 0; n < 2; ++n) _Pragma("unroll") for (int k = 0; k < 2; ++k) \
        acc[ai][bj][m][n] = __builtin_amdgcn_mfma_f32_16x16x32_bf16(Bt[n][k], At[m][k], acc[ai][bj][m][n], 0, 0, 0); __builtin_amdgcn_s_setprio(0); } while (0)
#define PG8_WAIT_V(n) asm volatile("s_waitcnt vmcnt(" #n ")" ::: "memory")
#define PG8_WAIT_L(n) asm volatile("s_waitcnt lgkmcnt(" #n ")" ::: "memory")
#define PG8_BAR __builtin_amdgcn_s_barrier()
#define PG8_SCHED __builtin_amdgcn_sched_barrier(0)
    Unit cur, nxt; int ui = 0;
    if (!S.next(0, cur)) return;
    f32x4 acc[2][2][4][2];
#pragma unroll
    for (int a = 0; a < 2; ++a)
#pragma unroll
        for (int b = 0; b < 2; ++b)
#pragma unroll
            for (int m = 0; m < 4; ++m)
#pragma unroll
                for (int n = 0; n < 2; ++n) acc[a][b][m][n] = (f32x4){0.f, 0.f, 0.f, 0.f};
    bf16x8 At[4][2], B0[2][2], B1[2][2];
    const char* cA = (const char*)g.A + (size_t)cur.pm * tstep; const char* cB = (const char*)g.Bt + (size_t)cur.pn * tstep;
    PG8_STAGE(PG8_SB(0, 0), cB, voffB); PG8_STAGE(PG8_SB(0, 1), cB + hstep, voffB); PG8_STAGE(PG8_SA(0, 0), cA, voffA); PG8_STAGE(PG8_SA(0, 1), cA + hstep, voffA);
    if (wr == 1) PG8_BAR;
    PG8_WAIT_V(2); PG8_BAR;
    PG8_STAGE(PG8_SB(1, 0), cB + kstep, voffB); PG8_STAGE(PG8_SA(1, 0), cA + kstep, voffA); PG8_STAGE(PG8_SB(1, 1), cB + hstep + kstep, voffB);
    PG8_WAIT_V(6); PG8_BAR;
    for (;;) {
        const bool has_next = S.next(ui + 1, nxt);
        const char* nA = has_next ? (const char*)g.A + (size_t)nxt.pm * tstep : cA; const char* nB = has_next ? (const char*)g.Bt + (size_t)nxt.pn * tstep : cB;
        for (int t = 0; t < nt; t += 2) {
            const bool last = (t == nt - 2);
            const char* a1 = cA + (size_t)(t + 1) * kstep;
            const char* a2 = last ? nA : cA + (size_t)(t + 2) * kstep; const char* b2 = last ? nB : cB + (size_t)(t + 2) * kstep;
            const char* a3 = a2 + kstep; const char* b3 = b2 + kstep;
            PG8_LDB(B0, 0, 0); PG8_LDB(B1, 0, 1); PG8_SCHED; PG8_LDA(At, 0, 0); PG8_STAGE(PG8_SA(1, 1), a1 + hstep, voffA);
            PG8_WAIT_V(8); PG8_WAIT_L(0); PG8_BAR; PG8_MMA(0, 0, At, B0); PG8_MMA(0, 1, At, B1); PG8_BAR; PG8_SCHED;
            PG8_LDA(At, 0, 1); PG8_STAGE(PG8_SB(0, 0), b2, voffB); PG8_STAGE(PG8_SB(0, 1), b2 + hstep, voffB); PG8_STAGE(PG8_SA(0, 0), a2, voffA);
            PG8_WAIT_V(8); PG8_WAIT_L(0); PG8_BAR; PG8_MMA(1, 0, At, B0); PG8_MMA(1, 1, At, B1); PG8_BAR; PG8_SCHED;
            PG8_LDB(B0, 1, 0); PG8_LDB(B1, 1, 1); PG8_SCHED; PG8_LDA(At, 1, 0); PG8_STAGE(PG8_SA(0, 1), a2 + hstep, voffA);
            PG8_WAIT_V(8); PG8_WAIT_L(0); PG8_BAR; PG8_MMA(0, 0, At, B0); PG8_MMA(0, 1, At, B1); PG8_BAR; PG8_SCHED;
            PG8_LDA(At, 1, 1); PG8_STAGE(PG8_SB(1, 0), b3, voffB); PG8_STAGE(PG8_SB(1, 1), b3 + hstep, voffB); PG8_STAGE(PG8_SA(1, 0), a3, voffA);
            PG8_WAIT_V(8); PG8_WAIT_L(0); PG8_BAR; PG8_MMA(1, 0, At, B0); PG8_MMA(1, 1, At, B1); PG8_BAR; PG8_SCHED;
        }
        if (wr == 0) PG8_BAR;
        E(acc, cur, wr, wc, fr, fq);
        if (!has_next) break;
#pragma unroll
        for (int a = 0; a < 2; ++a)
#pragma unroll
            for (int b = 0; b < 2; ++b)
#pragma unroll
                for (int m = 0; m < 4; ++m)
#pragma unroll
                    for (int n = 0; n < 2; ++n) acc[a][b][m][n] = (f32x4){0.f, 0.f, 0.f, 0.f};
        cur = nxt; cA = nA; cB = nB; ++ui;
        if (wr == 1) PG8_BAR;
    }
    PG8_WAIT_V(0);
    PG8_BAR;
#undef PG8_SA
#undef PG8_SB
#undef PG8_STAGE
#undef PG8_LDA
#undef PG8_LDB
#undef PG8_MMA
#undef PG8_WAIT_V
#undef PG8_WAIT_L
#undef PG8_BAR
#undef PG8_SCHED
}
}

__device__ __forceinline__ bf16_t* ws_w(const Params& p, int l, size_t off) { return (bf16_t*)(p.ws + WS_W + (size_t)l * LW_STRIDE + off); }
__device__ __forceinline__ bf16_t* ws_hb(const Params& p) { return (bf16_t*)(p.ws + WS_HB); }
__device__ __forceinline__ bf16_t* ws_mx(const Params& p) { return (bf16_t*)p.out; }
__device__ __forceinline__ float* ws_rs(const Params& p) { return (float*)(p.ws + WS_RS); }
__device__ __forceinline__ bf16_t* ws_big(const Params& p) { return (bf16_t*)(p.ws + WS_BIG); }
__device__ __forceinline__ bf16_t* ws_y(const Params& p) { return (bf16_t*)(p.ws + WS_BIG + BIG_Y); }
__device__ __forceinline__ bf16_t* ws_hgb(const Params& p) { return (bf16_t*)(p.ws + WS_HGB); }
__device__ __forceinline__ const float* xin_row(const Params& p, int row) { return row < 16 * SEQ ? p.in[0] + (size_t)row * DM : p.in[1] + (size_t)(row - 16 * SEQ) * DM; }

__device__ __forceinline__ void transpose_tile(const float* W, int N, int k0, int n0, bf16_t* Wt, int ldk, int nrow0, const float* gk, float* tile  ) {
    const int tid = TID();
#pragma unroll
    for (int i = 0; i < 2; ++i) { const int r = (tid >> 4) + 32 * i, c4 = (tid & 15) * 4;
        const f32x4 v = *(const f32x4*)(W + (size_t)(k0 + r) * N + n0 + c4); const float s = gk ? gk[k0 + r] : 1.0f;
        tile[r * 65 + c4 + 0] = v[0] * s; tile[r * 65 + c4 + 1] = v[1] * s; tile[r * 65 + c4 + 2] = v[2] * s; tile[r * 65 + c4 + 3] = v[3] * s; }
    __syncthreads();
    { const int n = tid >> 3, k8 = (tid & 7) * 8; u32x4 w;
      w.x = cvt_pk_bf16(tile[(k8 + 0) * 65 + n], tile[(k8 + 1) * 65 + n]); w.y = cvt_pk_bf16(tile[(k8 + 2) * 65 + n], tile[(k8 + 3) * 65 + n]);
      w.z = cvt_pk_bf16(tile[(k8 + 4) * 65 + n], tile[(k8 + 5) * 65 + n]); w.w = cvt_pk_bf16(tile[(k8 + 6) * 65 + n], tile[(k8 + 7) * 65 + n]);
      *(u32x4*)(Wt + (size_t)(nrow0 + n) * ldk + k0 + k8) = w; }
    __syncthreads();
}

__device__ __forceinline__ void phase_prep(const Params& p, unsigned char* lds) {
    float* tile = (float*)lds;
    const int tid = TID();
    int base = 0;
    for (int l = 0; l < 4; ++l) {
        const int idx = l >> 1; const bool even = (l & 1) == 0;
        for (int m = 0; m < 5; ++m) {
            const float* src; int K = 1024, N = 1024; const float* gk = nullptr; size_t dst = 0; int mode = 0;
            if (m == 0) { N = even ? 4096 : 2560; src = even ? p.in[3] + (size_t)idx * 1024 * 4096 : p.in[8] + (size_t)idx * 1024 * 2560; gk = p.in[2] + (l * 4 + 0) * 1024; dst = LW_WIN; }
            else if (m == 1) { src = even ? p.in[4] + (size_t)idx * 1024 * 1024 : p.in[9] + (size_t)idx * 1024 * 1024; dst = LW_WOUT; }
            else if (m == 2) { N = DFF; src = p.in[18] + (size_t)l * 1024 * DFF; gk = p.in[2] + (l * 4 + 2) * 1024; dst = LW_WGU; mode = 1; }
            else if (m == 3) { N = DFF; src = p.in[19] + (size_t)l * 1024 * DFF; gk = p.in[2] + (l * 4 + 2) * 1024; dst = LW_WGU; mode = 2; }
            else { K = DFF; src = p.in[20] + (size_t)l * DFF * 1024; dst = LW_WD; }
            const int nkt = K / 64, nnt = N / 64, ntile = nkt * nnt;
            int first = BID() - (base % GDIM()); if (first < 0) first += GDIM();
            for (int t = first; t < ntile; t += GDIM()) {
                const int kt = t % nkt, ntl = t / nkt; const int n0 = ntl * 64;
                int nrow0 = n0; if (mode) nrow0 = (n0 / 128) * 256 + (n0 % 128) + (mode == 2 ? 128 : 0);
                transpose_tile(src, N, kt * 64, n0, ws_w(p, l, dst), K, nrow0, gk, tile);
            }
            base += ntile;
        }
    }
    { bf16_t* rgw = (bf16_t*)(p.ws + WS_RGW);
      for (int e = BID() * NTHR + tid; e < 2 * 2 * 2 * 8 * 4096; e += GDIM() * NTHR) {
          const int c = e & 63, d = (e >> 6) & 63, blk = (e >> 12) & 7, ax = (e >> 15) & 1, dir = (e >> 16) & 1, idx = e >> 17;
          const float* src = ax ? p.in[14] : p.in[12];
          rgw[e] = f2bf(src[(((size_t)(idx * 2 + dir) * 8 + blk) * 64 + c) * 64 + d] * -1.44269504f); } }
    { const int wid = tid >> 6, lane = tid & 63; bf16_t* hb = ws_hb(p); float* rsv = ws_rs(p);
      for (int row = BID() * 8 + wid; row < NTOK; row += GDIM() * 8) {
          const float* xr = xin_row(p, row); f32x4 v[4]; float ss = 0.f;
#pragma unroll
          for (int i = 0; i < 4; ++i) { v[i] = *(const f32x4*)(xr + i * 256 + lane * 4); ss += v[i][0] * v[i][0] + v[i][1] * v[i][1] + v[i][2] * v[i][2] + v[i][3] * v[i][3]; }
          ss = wave_sum(ss); if (lane == 0) rsv[row] = rsqrtf(ss * (1.0f / 1024.0f) + 1e-6f);
#pragma unroll
          for (int i = 0; i < 4; ++i) { u32x2 w; w.x = cvt_pk_bf16(v[i][0], v[i][1]); w.y = cvt_pk_bf16(v[i][2], v[i][3]); *(u32x2*)(hb + (size_t)row * DM + i * 256 + lane * 4) = w; } } }
}

__device__ __forceinline__ void phase_rowpass(const Params& p, int layer, int which  ) {
    const int tid = TID(), wid = tid >> 6, lane = tid & 63;
    const bf16_t* Y = ws_y(p); bf16_t* xb = ws_hb(p); float* rsv = ws_rs(p);
    const float* gp = p.in[2] + (layer * 4 + (which ? 3 : 1)) * 1024;
    const bool last = (layer == 3 && which == 1);
    float gv[2][8];
#pragma unroll
    for (int i = 0; i < 2; ++i)
#pragma unroll
        for (int e = 0; e < 8; ++e) gv[i][e] = gp[i * 512 + lane * 8 + e];
    for (int row = BID() * 8 + wid; row < NTOK; row += GDIM() * 8) {
        float xv[2][8], yv[2][8]; float ssy = 0.f;
#pragma unroll
        for (int i = 0; i < 2; ++i) { const bf16x8 xw = *(const bf16x8*)(xb + (size_t)row * DM + i * 512 + lane * 8), yw = *(const bf16x8*)(Y + (size_t)row * DM + i * 512 + lane * 8);
#pragma unroll
            for (int e = 0; e < 8; ++e) { xv[i][e] = bf2f((bf16_t)xw[e]); yv[i][e] = bf2f((bf16_t)yw[e]); ssy += yv[i][e] * yv[i][e]; } }
        ssy = wave_sum(ssy); const float rsy = rsqrtf(ssy * (1.0f / 1024.0f) + 1e-6f);
        float ssx = 0.f;
#pragma unroll
        for (int i = 0; i < 2; ++i)
#pragma unroll
            for (int e = 0; e < 8; ++e) { xv[i][e] = xv[i][e] + yv[i][e] * rsy * gv[i][e]; ssx += xv[i][e] * xv[i][e]; }
        if (last) {
#pragma unroll
            for (int i = 0; i < 2; ++i) { float* op = p.out + (size_t)row * DM + i * 512 + lane * 8;
                *(f32x4*)op = (f32x4){xv[i][0], xv[i][1], xv[i][2], xv[i][3]}; *(f32x4*)(op + 4) = (f32x4){xv[i][4], xv[i][5], xv[i][6], xv[i][7]}; }
        } else {
            ssx = wave_sum(ssx); if (lane == 0) rsv[row] = rsqrtf(ssx * (1.0f / 1024.0f) + 1e-6f);
#pragma unroll
            for (int i = 0; i < 2; ++i) { u32x4 w; w.x = cvt_pk_bf16(xv[i][0], xv[i][1]); w.y = cvt_pk_bf16(xv[i][2], xv[i][3]); w.z = cvt_pk_bf16(xv[i][4], xv[i][5]); w.w = cvt_pk_bf16(xv[i][6], xv[i][7]);
                *(u32x4*)(xb + (size_t)row * DM + i * 512 + lane * 8) = w; }
        }
    }
}

__device__ __forceinline__ void phase_gemm(const Params& p, unsigned char* lds, int layer, int which  ) {
    const bool even = (layer & 1) == 0;
    pg8::Gemm g; g.M = NTOK; pg8::StaticOrder S;
    LAS unsigned char* l3 = (LAS unsigned char*)lds;
    if (which == 2) { g.A = ws_hb(p); g.Bt = ws_w(p, layer, LW_WGU); g.N = 2 * DFF; g.K = 1024; S.init(g.M, g.N, GDIM(), BID());
        pg8::EpiSwiGLU E{ws_big(p), DFF, ws_rs(p)}; pg8::gemm_phase(l3, g, S, E); }
    else { pg8::EpiStore E;
        if (which == 0) { g.A = ws_hb(p); g.Bt = ws_w(p, layer, LW_WIN); g.N = even ? ZLD_E : ZLD_O; g.K = 1024; E.O = ws_big(p); E.ldc = g.N; E.rs = ws_rs(p); }
        else if (which == 1) { g.A = ws_mx(p); g.Bt = ws_w(p, layer, LW_WOUT); g.N = 1024; g.K = 1024; E.O = ws_y(p); E.ldc = 1024; E.rs = nullptr; }
        else { g.A = ws_big(p); g.Bt = ws_w(p, layer, LW_WD); g.N = 1024; g.K = DFF; E.O = ws_y(p); E.ldc = 1024; E.rs = nullptr; }
        S.init(g.M, g.N, GDIM(), BID()); pg8::gemm_phase(l3, g, S, E); }
}

__device__ __forceinline__ void stage_vt(bf16_t* vt, const bf16x8 (&v)[4], int lane) {
#pragma unroll
    for (int i = 0; i < 4; ++i) { const int key = (lane >> 3) + 8 * i; *(bf16x8*)(vt + key * 80 + (lane & 7) * 8) = v[i]; }
}
typedef short s16x4 __attribute__((ext_vector_type(4)));
__device__ __forceinline__ bf16x8 read_vT(const bf16_t* vt, int dt, int lane) {
    const int fr = lane & 15, g = lane >> 4, q = fr >> 2, pq = fr & 3;
    const bf16_t* a0 = vt + (4 * g + q) * 80 + 16 * dt + 4 * pq;
    const s16x4 lo = __builtin_amdgcn_ds_read_tr16_b64_v4i16((LAS s16x4*)a0);
    const s16x4 hi = __builtin_amdgcn_ds_read_tr16_b64_v4i16((LAS s16x4*)(a0 + 16 * 80));
    return __builtin_shufflevector(lo, hi, 0, 1, 2, 3, 4, 5, 6, 7);
}

constexpr float LOG2E = 1.44269504f, LN2 = 0.69314718f;
__device__ __forceinline__ void na_wave(const Params& p, const float* rpbs  , bf16_t* vt, int seq, int r, int h, int gq, int lane) {
    const int fr = lane & 15, g = lane >> 4;
    const int c0 = gq == 0 ? 0 : (gq == 1 ? 8 : (gq == 2 ? 24 : 32));
    const int kr0 = min(max(r - 4, 0), 56);
    const int c = 16 * gq + fr, cs = min(max(c - 8, 0), 48);
    const bf16_t* zb = ws_big(p) + ((size_t)seq * SEQ + kr0 * 64 + c0) * ZLD_E + h * 64;
    const unsigned qoff = (unsigned)((r - kr0) * 64 + 16 * gq - c0 + fr) * ZLD_E + 8u * g;
    const bf16x8 q0 = *(const bf16x8*)(zb + qoff), q1 = *(const bf16x8*)(zb + qoff + 32);
    const unsigned koff = (unsigned)fr * ZLD_E + 512u + 8u * g;
    f32x4 s[16];
#pragma unroll
    for (int t = 0; t < 16; ++t) { const int kr = t >> 1, hf = t & 1;
        const bf16_t* kp = zb + (koff + (unsigned)((kr * 64 + 16 * hf) * ZLD_E));
        const bf16x8 k0 = *(const bf16x8*)kp, k1 = *(const bf16x8*)(kp + 32);
        f32x4 a = (f32x4){0.f, 0.f, 0.f, 0.f}; a = mfma16(k0, q0, a); a = mfma16(k1, q1, a); s[t] = a; }
    const unsigned voff = (unsigned)(lane >> 3) * ZLD_E + 1024u + 8u * (lane & 7);
    bf16x8 vb3[3][4];
#pragma unroll
    for (int kk2 = 0; kk2 < 2; ++kk2)
#pragma unroll
        for (int i = 0; i < 4; ++i) vb3[kk2][i] = *(const bf16x8*)(zb + (voff + (unsigned)((kk2 * 64 + 8 * i) * ZLD_E)));
    const float* rp = rpbs + (h * 15 + kr0 - r + 7) * 31 + (c0 - 16 * gq + 4 * g - fr + 15);
    const int mk = c0 + 4 * g - cs;
    float m = -1e30f;
#pragma unroll
    for (int t = 0; t < 16; ++t) { const int kr = t >> 1, hf = t & 1;
#pragma unroll
        for (int j = 0; j < 4; ++j) { const bool ok = (unsigned)(mk + 16 * hf + j) < 16u;
            float v = s[t][j] * (0.125f * LOG2E) + rp[kr * 31 + 16 * hf + j]; v = ok ? v : -1e30f; s[t][j] = v; m = fmaxf(m, v); } }
    m = fmaxf(m, __shfl_xor(m, 16)); m = fmaxf(m, __shfl_xor(m, 32));
    float l = 0.f;
#pragma unroll
    for (int t = 0; t < 16; ++t)
#pragma unroll
        for (int j = 0; j < 4; ++j) { const float e = __builtin_amdgcn_exp2f(s[t][j] - m); s[t][j] = e; l += e; }
    l += __shfl_xor(l, 16); l += __shfl_xor(l, 32);
    f32x4 o[4];
#pragma unroll
    for (int dt = 0; dt < 4; ++dt) o[dt] = (f32x4){0.f, 0.f, 0.f, 0.f};
#pragma unroll
    for (int kr = 0; kr < 8; ++kr) {
        if (kr + 2 < 8) {
#pragma unroll
            for (int i = 0; i < 4; ++i) vb3[(kr + 2) % 3][i] = *(const bf16x8*)(zb + (voff + (unsigned)(((kr + 2) * 64 + 8 * i) * ZLD_E))); }
        WAVE_SYNC();
        stage_vt(vt, vb3[kr % 3], lane);
        WAVE_SYNC();
        const bf16x8 pb = pack8(s[2 * kr], s[2 * kr + 1]);
#pragma unroll
        for (int dt = 0; dt < 4; ++dt) { const bf16x8 va = read_vT(vt, dt, lane); o[dt] = mfma16(va, pb, o[dt]); }
    }
    const float inv = __builtin_amdgcn_rcpf(l);
    bf16_t* mb = ws_mx(p) + ((size_t)seq * SEQ + r * 64 + 16 * gq) * DM + h * 64;
    const unsigned ooff = (unsigned)fr * DM + 4u * g;
#pragma unroll
    for (int dt = 0; dt < 4; ++dt) { u32x2 w; w.x = cvt_pk_bf16(o[dt][0] * inv, o[dt][1] * inv); w.y = cvt_pk_bf16(o[dt][2] * inv, o[dt][3] * inv); *(u32x2*)(mb + (ooff + 16u * dt)) = w; }
}

constexpr int HG_QLD = 136, HG_TLD = 72;
__device__ __forceinline__ void hgrn_item(const Params& p, unsigned char* lds, int lidx, int item) {
    const int tid = TID(), wid = tid >> 6, lane = tid & 63, fr = lane & 15, g = lane >> 4;
    const int seq = item >> 3, dir = (item >> 2) & 1, head = item & 3;
    bf16_t* QA = (bf16_t*)lds; bf16_t* QS = QA + 64 * HG_QLD; bf16_t* KT = QS + 64 * HG_QLD; bf16_t* KH = KT + 64 * HG_QLD; bf16_t* VT = KH + 128 * HG_TLD; bf16_t* AM = VT + 128 * HG_TLD;
    float* BC = (float*)(AM + 64 * HG_TLD); float* QT = BC + 128;
    const bf16_t* Z = ws_big(p);
    const int d = tid & 127, tq = tid >> 7, ch = head * 128 + d;
    float lb = 0.f;
    if (lidx == 1) { const float l0 = p.in[6][(0 * 2 + dir) * 512 + ch], l1 = p.in[6][(1 * 2 + dir) * 512 + ch]; lb = 1.0f / (1.0f + expf(l0 - l1)); }
    const float oml = 1.0f - lb;
    f32x4 st[8];
#pragma unroll
    for (int i = 0; i < 8; ++i) st[i] = (f32x4){0.f, 0.f, 0.f, 0.f};
    bf16_t* Od = dir == 0 ? ws_mx(p) + 512 : ws_hgb(p); const int ldo = dir == 0 ? DM : 512;
    const size_t tokb = (size_t)seq * SEQ;
    const int zcol = (dir ? 2560 : 2048) + ch;
#define LDS_BAR() do { asm volatile("s_waitcnt lgkmcnt(0)" ::: "memory"); __builtin_amdgcn_s_barrier(); asm volatile("" ::: "memory"); } while (0)
    bf16_t* RAW = (bf16_t*)(QT + 512);
#define HG_LOAD(ck_) do { const bf16_t* cb = Z + (tokb + (size_t)(dir == 0 ? (ck_) * 64 : SEQ - 64 - (ck_) * 64)) * ZLD_E;     \
        _Pragma("unroll") for (int k2 = 0; k2 < 2; ++k2) { const int id = tid + 512 * k2; const int rr = id >> 4, c8 = (id & 15) * 8; \
        const unsigned ro = (unsigned)(dir == 0 ? rr : 63 - rr) * ZLD_E + (unsigned)(head * 128 + c8); \
        rawr[0][k2] = *(const u32x4*)(cb + ro + 1536u); rawr[1][k2] = *(const u32x4*)(cb + ro + (dir ? 2560u : 2048u)); rawr[2][k2] = *(const u32x4*)(cb + ro + 3072u); } } while (0)
    u32x4 rawr[3][2];
    HG_LOAD(0);
    for (int ck = 0; ck < 64; ++ck) {
        float lf[16], qv[16], kk[16]; unsigned cv[8];
#pragma unroll
        for (int k2 = 0; k2 < 2; ++k2) { const int id = tid + 512 * k2; const int rr = id >> 4, c8 = (id & 15) * 8;
#pragma unroll
            for (int a = 0; a < 3; ++a) *(u32x4*)(RAW + (a * 64 + rr) * HG_QLD + c8) = rawr[a][k2]; }
        LDS_BAR();
        if (ck + 1 < 64) HG_LOAD(ck + 1);
#pragma unroll
        for (int e = 0; e < 16; ++e) { const int i = 16 * tq + e;
            const float q = bf2f(RAW[(0 * 64 + i) * HG_QLD + d]), z = bf2f(RAW[(1 * 64 + i) * HG_QLD + d]);
            const float ez = fexp(-z), sg = __builtin_amdgcn_rcpf(1.0f + ez); const float f = lb + oml * sg;
            lf[e] = __builtin_amdgcn_logf(f); kk[e] = 1.0f - f;     qv[e] = q * __builtin_amdgcn_rcpf(1.0f + fexp(-q)); }
#pragma unroll
        for (int e2 = 0; e2 < 8; ++e2) { const int i = 16 * tq + 2 * e2; cv[e2] = (unsigned)RAW[(2 * 64 + i) * HG_QLD + d] | ((unsigned)RAW[(2 * 64 + i + 1) * HG_QLD + d] << 16); }
#pragma unroll
        for (int e = 1; e < 16; ++e) lf[e] += lf[e - 1];
        QT[tq * 128 + d] = lf[15];
        LDS_BAR();
        const float t0 = QT[d], t1 = QT[128 + d], t2 = QT[256 + d], t3 = QT[384 + d];
        const float off = tq == 0 ? 0.f : (tq == 1 ? t0 : (tq == 2 ? t0 + t1 : t0 + t1 + t2));
        const float bref = t0 + t1, bC = t0 + t1 + t2 + t3;
        const float eref = __builtin_amdgcn_exp2f(bref), ecr = __builtin_amdgcn_exp2f(bC - bref);
        float kh[16];
#pragma unroll
        for (int e = 0; e < 16; ++e) { const int i = 16 * tq + e; const float b = lf[e] + off;
            const float e1 = __builtin_amdgcn_exp2f(fminf(fmaxf(b - bref, -115.f), 115.f)); const float r1 = __builtin_amdgcn_rcpf(e1);
            QA[i * HG_QLD + d] = f2bf(qv[e] * e1); QS[i * HG_QLD + d] = f2bf(qv[e] * e1 * eref);
            KT[i * HG_QLD + d] = f2bf(kk[e] * r1); kh[e] = kk[e] * r1 * ecr; }
        { u32x4 w0, w1; w0.x = cvt_pk_bf16(kh[0], kh[1]); w0.y = cvt_pk_bf16(kh[2], kh[3]); w0.z = cvt_pk_bf16(kh[4], kh[5]); w0.w = cvt_pk_bf16(kh[6], kh[7]);
          w1.x = cvt_pk_bf16(kh[8], kh[9]); w1.y = cvt_pk_bf16(kh[10], kh[11]); w1.z = cvt_pk_bf16(kh[12], kh[13]); w1.w = cvt_pk_bf16(kh[14], kh[15]);
          *(u32x4*)(KH + d * HG_TLD + 16 * tq) = w0; *(u32x4*)(KH + d * HG_TLD + 16 * tq + 8) = w1;
          u32x4 x0, x1; x0.x = cv[0]; x0.y = cv[1]; x0.z = cv[2]; x0.w = cv[3]; x1.x = cv[4]; x1.y = cv[5]; x1.z = cv[6]; x1.w = cv[7];
          *(u32x4*)(VT + d * HG_TLD + 16 * tq) = x0; *(u32x4*)(VT + d * HG_TLD + 16 * tq + 8) = x1; }
        if (tq == 0) BC[d] = __builtin_amdgcn_exp2f(bC);
        LDS_BAR();
        { const int ti = wid >> 1, sj0 = 2 * (wid & 1);
          f32x4 a0 = (f32x4){0.f, 0.f, 0.f, 0.f}, a1 = a0;
#pragma unroll
          for (int ks = 0; ks < 4; ++ks) { const bf16x8 qa = *(const bf16x8*)(QA + (16 * ti + fr) * HG_QLD + 32 * ks + 8 * g);
              const bf16x8 kb0 = *(const bf16x8*)(KT + (16 * sj0 + fr) * HG_QLD + 32 * ks + 8 * g), kb1 = *(const bf16x8*)(KT + (16 * sj0 + 16 + fr) * HG_QLD + 32 * ks + 8 * g);
              a0 = mfma16(qa, kb0, a0); a1 = mfma16(qa, kb1, a1); }
#pragma unroll
          for (int j = 0; j < 4; ++j) { const int t = 16 * ti + 4 * g + j, s0 = 16 * sj0 + fr, s1 = s0 + 16;
              AM[t * HG_TLD + s0] = f2bf(s0 <= t ? a0[j] : 0.f); AM[t * HG_TLD + s1] = f2bf(s1 <= t ? a1[j] : 0.f); } }
        LDS_BAR();
        bf16_t* ob = Od + (tokb + (size_t)(dir == 0 ? ck * 64 : SEQ - 64 - ck * 64)) * ldo;
        bf16x8 vb[2];
#pragma unroll
        for (int ks = 0; ks < 2; ++ks) vb[ks] = *(const bf16x8*)(VT + (16 * wid + fr) * HG_TLD + 32 * ks + 8 * g);
        bf16x8 sb[4];
#pragma unroll
        for (int pp = 0; pp < 4; ++pp) sb[pp] = pack8(st[2 * pp], st[2 * pp + 1]);
#pragma unroll
        for (int ti = 0; ti < 4; ++ti) {
            f32x4 o = (f32x4){0.f, 0.f, 0.f, 0.f};
#pragma unroll
            for (int ks = 0; ks < 2; ++ks) { const bf16x8 am = *(const bf16x8*)(AM + (16 * ti + fr) * HG_TLD + 32 * ks + 8 * g); o = mfma16(am, vb[ks], o); }
#pragma unroll
            for (int pp = 0; pp < 4; ++pp) { const bf16x4 lo = *(const bf16x4*)(QS + (16 * ti + fr) * HG_QLD + 32 * pp + 4 * g), hi = *(const bf16x4*)(QS + (16 * ti + fr) * HG_QLD + 32 * pp + 16 + 4 * g);
                const bf16x8 qs = __builtin_shufflevector(lo, hi, 0, 1, 2, 3, 4, 5, 6, 7); o = mfma16(qs, sb[pp], o); }
#pragma unroll
            for (int j = 0; j < 4; ++j) { const int i = 16 * ti + 4 * g + j;
                ob[(unsigned)(dir == 0 ? i : 63 - i) * (unsigned)ldo + (unsigned)(head * 128 + 16 * wid + fr)] = f2bf(o[j]); }
        }
#pragma unroll
        for (int i = 0; i < 8; ++i) { const f32x4 dec = *(const f32x4*)(BC + 16 * i + 4 * g); st[i] = st[i] * dec;
#pragma unroll
            for (int ks = 0; ks < 2; ++ks) { const bf16x8 khv = *(const bf16x8*)(KH + (16 * i + fr) * HG_TLD + 32 * ks + 8 * g); st[i] = mfma16(khv, vb[ks], st[i]); } }
        LDS_BAR();
    }
}
static_assert((3 * 64 * HG_QLD + 2 * 128 * HG_TLD + 64 * HG_TLD) * 2 + (128 + 512) * 4 + 3 * 64 * HG_QLD * 2 <= LDS_BYTES, "hgrn lds");

__device__ __forceinline__ void phase_even_mix(const Params& p, unsigned char* lds, int lidx) {
    const int tid = TID(), wid = __builtin_amdgcn_readfirstlane(tid >> 6), lane = tid & 63;
    for (int rep = 0; rep < ((DBG_REP & 8) ? 2 : 1); ++rep)
    for (int item = BID(); item < 160; item += GDIM()) hgrn_item(p, lds, lidx, item);
    __syncthreads();
    float* rpbs = (float*)lds + 64; bf16_t* vt = (bf16_t*)(lds + 16384) + wid * (64 * 40); int* slot = (int*)(lds + 15872);
    const float* rpb = p.in[5] + (size_t)lidx * 8 * 15 * 31;
    for (int i = tid; i < 8 * 15 * 31; i += NTHR) rpbs[i] = rpb[i] * LOG2E;
    unsigned* ctrs = (unsigned*)(p.ws + WS_CTL) + 16 + lidx * 8;
    const unsigned xcc = ((unsigned)__builtin_amdgcn_s_getreg((3 << 11) | 20)) & 7u;
    { unsigned kq = 0; int j;
      __syncthreads();
      if (tid == 0) *slot = (int)atomicAdd(ctrs + ((xcc + kq) & 7u), 1u);
      __syncthreads();
      j = __builtin_amdgcn_readfirstlane(*slot);
      for (;;) {
          while (j >= 10 * 64 && kq < 7u) { ++kq;
              __syncthreads();
              if (tid == 0) *slot = (int)atomicAdd(ctrs + ((xcc + kq) & 7u), 1u);
              __syncthreads();
              j = __builtin_amdgcn_readfirstlane(*slot); }
          if (j >= 10 * 64) break;
          const unsigned q = (xcc + kq) & 7u;
          int jn = 0; if (tid == 0) jn = (int)atomicAdd(ctrs + q, 1u);
          const int pi = (int)q + 8 * (j >> 6), r = j & 63, seq = pi >> 2, hp = pi & 3;
          na_wave(p, rpbs, vt, seq, r, 2 * hp + (wid >> 2), wid & 3, lane);
          __syncthreads();
          if (tid == 0) *slot = jn;
          __syncthreads();
          j = __builtin_amdgcn_readfirstlane(*slot);
      } }
}

__device__ __forceinline__ void phase_hgrn_fin(const Params& p, int lidx) {
    const int tid = TID(), wid = tid >> 6, lane = tid & 63;
    const bf16_t* Z = ws_big(p); bf16_t* Mx = ws_mx(p); const bf16_t* Ob = ws_hgb(p);
    const float* on = p.in[7] + lidx * 128 + (lane & 15) * 8;
    float gn[8];
#pragma unroll
    for (int e = 0; e < 8; ++e) gn[e] = on[e];
    for (int row = BID() * 8 + wid; row < NTOK; row += GDIM() * 8) {
        const bf16x8 a = *(const bf16x8*)(Mx + (size_t)row * DM + 512 + lane * 8), b = *(const bf16x8*)(Ob + (size_t)row * 512 + lane * 8), gz = *(const bf16x8*)(Z + (size_t)row * ZLD_E + 3584 + lane * 8);
        float o[8]; float ss = 0.f;
#pragma unroll
        for (int e = 0; e < 8; ++e) { o[e] = bf2f((bf16_t)a[e]) + bf2f((bf16_t)b[e]); ss += o[e] * o[e]; }
        ss += __shfl_xor(ss, 1); ss += __shfl_xor(ss, 2); ss += __shfl_xor(ss, 4); ss += __shfl_xor(ss, 8);
        const float rs = rsqrtf(ss * (1.0f / 128.0f) + 1e-6f);
        float r[8];
#pragma unroll
        for (int e = 0; e < 8; ++e) r[e] = o[e] * rs * gn[e] * siluf_(bf2f((bf16_t)gz[e]));
        u32x4 w; w.x = cvt_pk_bf16(r[0], r[1]); w.y = cvt_pk_bf16(r[2], r[3]); w.z = cvt_pk_bf16(r[4], r[5]); w.w = cvt_pk_bf16(r[6], r[7]);
        *(u32x4*)(Mx + (size_t)row * DM + 512 + lane * 8) = w;
    }
}

constexpr int RG_YLD = 72, RG_ALD = 68, RG_WAVE_LDS = 64 * RG_YLD * 2 + 2 * 16 * RG_ALD * 4;
static_assert(8 * RG_WAVE_LDS <= LDS_BYTES, "rg lds");
__device__ __forceinline__ float gelu_tanh(float x) { const float u = 0.7978845608f * (x + 0.044715f * x * x * x); const float t = 1.0f - 2.0f * __builtin_amdgcn_rcpf(1.0f + fexp(2.0f * u)); return 0.5f * x * (1.0f + t); }
template <int MODE>
__device__ __forceinline__ void rg_wave(const Params& p, unsigned char* wl, int idx, int seq, int ck, int blk, int lane) {
    const int fr = lane & 15, g = lane >> 4;
    bf16_t* ybf = (bf16_t*)wl; float* auA = (float*)(wl + 64 * RG_YLD * 2); float* auU = auA + 16 * RG_ALD;
    const bf16_t* Z = ws_big(p); bf16_t* Mx = ws_mx(p);
    float* SA = (float*)(p.ws + WS_RGS); float* SH = SA + RGS_ONE / 4; const float* HI = SH + RGS_ONE / 4;
    const size_t tokb = (size_t)seq * SEQ; const int t0 = ck * 64, ch = blk * 64 + lane;
    {
      const float* cw = p.in[10] + idx * 4 * 512; const float w0 = cw[ch], w1 = cw[512 + ch], w2 = cw[1024 + ch], w3 = cw[1536 + ch], cb = p.in[11][idx * 512 + ch];
      const bf16_t* xb = Z + tokb * ZLD_O + 512 + blk * 64;
      u32x4 xr[9];
#pragma unroll
      for (int k = 0; k < 9; ++k) { const int pc = lane + 64 * k; const int rr = pc >> 3, c8 = (pc & 7) * 8; const int t = t0 - 2 + rr;
          xr[k] = (u32x4){0u, 0u, 0u, 0u};
          if (pc < 67 * 8 && t >= 0 && t < SEQ) xr[k] = *(const u32x4*)(xb + (size_t)t * ZLD_O + c8); }
#pragma unroll
      for (int k = 0; k < 9; ++k) { const int pc = lane + 64 * k; const int rr = pc >> 3, c8 = (pc & 7) * 8; if (pc < 67 * 8) *(u32x4*)(ybf + rr * RG_YLD + c8) = xr[k]; }
      WAVE_SYNC();
      float xm2 = bf2f(ybf[0 * RG_YLD + lane]), xm1 = bf2f(ybf[1 * RG_YLD + lane]), x0 = bf2f(ybf[2 * RG_YLD + lane]);
#pragma unroll 8
      for (int t = 0; t < 64; ++t) { const float x1 = bf2f(ybf[(t + 3) * RG_YLD + lane]); const float y = w0 * xm2 + w1 * xm1 + w2 * x0 + w3 * x1 + cb;
          ybf[t * RG_YLD + lane] = f2bf(y); xm2 = xm1; xm1 = x0; x0 = x1; }
    }
    WAVE_SYNC();
    const bf16_t* rgw = (const bf16_t*)(p.ws + WS_RGW) + (size_t)idx * 131072;
    const bf16_t* zgb = Z + (tokb + t0) * ZLD_O + blk * 64; bf16_t* mxb = Mx + (tokb + t0) * DM + blk * 64;
#pragma unroll
    for (int dir = 0; dir < 2; ++dir) {
        const bf16_t* wa_ = rgw + ((dir * 2 + 0) * 8 + blk) * 4096; const bf16_t* wx_ = rgw + ((dir * 2 + 1) * 8 + blk) * 4096;
        bf16x8 wa[4][2], wx[4][2]; float ba[4], bx[4], sp8[4];
#pragma unroll
        for (int n = 0; n < 4; ++n) {
#pragma unroll
            for (int ks = 0; ks < 2; ++ks) { wa[n][ks] = *(const bf16x8*)(wa_ + (16 * n + fr) * 64 + 32 * ks + 8 * g); wx[n][ks] = *(const bf16x8*)(wx_ + (16 * n + fr) * 64 + 32 * ks + 8 * g); }
            const int chn = (idx * 2 + dir) * 512 + blk * 64 + 16 * n + fr; ba[n] = p.in[13][chn] * -1.44269504f; bx[n] = p.in[15][chn] * -1.44269504f; sp8[n] = -8.0f * 1.44269504f * log1pf(expf(-p.in[16][chn])); }
        const int sidx = ((seq * 64 + ck) * 2 + dir) * 512 + ch;
        float h = 0.f, P = 1.f; if (MODE == 1) h = HI[sidx];
        const int first = dir ? SEQ - 1 : 0;
#pragma unroll 1
        for (int tti = 0; tti < 4; ++tti) { const int tt = dir ? 3 - tti : tti;
            const bool has_first = __builtin_amdgcn_readfirstlane((int)((unsigned)(first - (t0 + 16 * tt)) < 16u)) != 0;
            bf16x8 ya[2];
#pragma unroll
            for (int ks = 0; ks < 2; ++ks) ya[ks] = *(const bf16x8*)(ybf + (16 * tt + fr) * RG_YLD + 32 * ks + 8 * g);
#define RG_ELEMS(FIRSTCHK) do { _Pragma("unroll") for (int n = 0; n < 4; ++n) { f32x4 ar = (f32x4){ba[n], ba[n], ba[n], ba[n]}, ai = (f32x4){bx[n], bx[n], bx[n], bx[n]};     \
                _Pragma("unroll") for (int ks = 0; ks < 2; ++ks) { ar = mfma16(ya[ks], wa[n][ks], ar); ai = mfma16(ya[ks], wx[n][ks], ai); } \
                _Pragma("unroll") for (int j = 0; j < 4; ++j) { const int tok = 16 * tt + 4 * g + j; const float yv = bf2f(ybf[tok * RG_YLD + 16 * n + fr]); \
                    const float r = __builtin_amdgcn_rcpf(1.0f + __builtin_amdgcn_exp2f(ar[j])), ii = __builtin_amdgcn_rcpf(1.0f + __builtin_amdgcn_exp2f(ai[j])); \
                    const float a = __builtin_amdgcn_exp2f(r * sp8[n]);       \
                    const float em = __builtin_fmaf(-a, a, 1.0f);              \
                    float sc = __builtin_amdgcn_sqrtf(em); if (FIRSTCHK) { if (t0 + tok == first) sc = 1.0f; } \
                    auA[(4 * g + j) * RG_ALD + 16 * n + fr] = a; auU[(4 * g + j) * RG_ALD + 16 * n + fr] = sc * ii * yv; } } } while (0)
            if (has_first) RG_ELEMS(true); else RG_ELEMS(false);
#undef RG_ELEMS
            WAVE_SYNC();
            bf16_t gcv[16], pv[16];
            const unsigned zo = (unsigned)(16 * tt * ZLD_O) + (unsigned)lane, mo = (unsigned)(16 * tt * DM) + (unsigned)lane;
            if (MODE == 1 && dir == 1) {
#pragma unroll
                for (int s = 0; s < 16; ++s) { gcv[s] = zgb[zo + (unsigned)(s * ZLD_O)]; pv[s] = mxb[mo + (unsigned)(s * DM)]; } }
#pragma unroll
            for (int si = 0; si < 16; ++si) { const int s = dir ? 15 - si : si; const float a = auA[s * RG_ALD + lane], u = auU[s * RG_ALD + lane]; h = a * h + u; P *= a;
                if (MODE == 1) { if (dir == 0) mxb[mo + (unsigned)(s * DM)] = f2bf(h); else mxb[mo + (unsigned)(s * DM)] = f2bf((bf2f(pv[s]) + h) * gelu_tanh(bf2f(gcv[s]))); } }
            WAVE_SYNC();
        }
        if (MODE == 0) { SA[sidx] = P; SH[sidx] = h; }
    }
}

__device__ __forceinline__ void phase_rg_carry(const Params& p) {
    float* SA = (float*)(p.ws + WS_RGS); float* SH = SA + RGS_ONE / 4; float* HI = SH + RGS_ONE / 4;
    for (int e = BID() * NTHR + TID(); e < NSEQ * 2 * 512; e += GDIM() * NTHR) { const int ch = e & 511, dir = (e >> 9) & 1, seq = e >> 10;
        float H = 0.f;
        for (int i = 0; i < 64; ++i) { const int ck = dir ? 63 - i : i; const int sidx = ((seq * 64 + ck) * 2 + dir) * 512 + ch; HI[sidx] = H; H = SA[sidx] * H + SH[sidx]; } }
}

constexpr int DL_OB = 0, DL_LSE = 3 * 256 * 64 * 2, DL_TB = DL_LSE + 3 * 256 * 4, DL_VT = DL_TB + 2048, DL_END = DL_VT + 8 * 64 * 40 * 2;
static_assert(DL_END <= LDS_BYTES, "dil lds");
struct DilTile { int br, dsh, L, res, jj0; };
__device__ __forceinline__ DilTile dil_tile(int it, int blk) { DilTile t; t.br = it >> 4; const int ti = it & 15; t.dsh = 2 * t.br; t.L = SEQ >> t.dsh;
    if (t.br == 0) { t.res = 0; t.jj0 = blk * 256 + 16 * ti; } else if (t.br == 1) { t.res = ti >> 2; t.jj0 = blk * 64 + 16 * (ti & 3); } else { t.res = ti; t.jj0 = blk * 16; }
    return t; }
__device__ __forceinline__ void dil_item(const Params& p, unsigned char* lds, int seq, int blk, int h) {
    const int tid = TID(), wid = __builtin_amdgcn_readfirstlane(tid >> 6), lane = tid & 63, fr = lane & 15, g = lane >> 4;
    bf16_t* OB = (bf16_t*)(lds + DL_OB); float* LSE = (float*)(lds + DL_LSE); float* TB = (float*)(lds + DL_TB); bf16_t* vt = (bf16_t*)(lds + DL_VT) + wid * (64 * 40);
    for (int i = tid; i < 3 * 160; i += NTHR) { const int b3 = i / 160, rel = i % 160 - 79;
        TB[i] = (rel >= -64 && rel <= 64) ? p.in[17][(int)T5_BUCKET[b3 * 129 + rel + 64] * 8 + h] * LOG2E : -1e30f; }
    __syncthreads();
    const bf16_t* Z = ws_big(p); bf16_t* Mx = ws_mx(p);
    const size_t tokb = (size_t)seq * SEQ;
    const bf16_t* zq = Z + tokb * ZLD_O + h * 64;
#define DIL_KQLOAD(T) do { const bf16_t* zr_ = zq + T.res * ZLD_O; const unsigned qo_ = (unsigned)((T.jj0 + fr) << T.dsh) * ZLD_O + 1024u + 8u * g; qf[0] = *(const bf16x8*)(zr_ + qo_); qf[1] = *(const bf16x8*)(zr_ + qo_ + 32); \
        _Pragma("unroll") for (int pq_ = 0; pq_ < 5; ++pq_) _Pragma("unroll") for (int i = 0; i < 4; ++i) { const int key = (lane >> 3) + 8 * i; const int kjj_ = min(max(T.jj0 - 64 + 32 * pq_ + key, 0), T.L - 1); \
            if (pq_ == 4 && i >= 2) kst[pq_][i] = (bf16x8){0, 0, 0, 0, 0, 0, 0, 0}; \
            else kst[pq_][i] = *(const bf16x8*)(zr_ + ((unsigned)(kjj_ << T.dsh) * ZLD_O + 1536u + 8u * (lane & 7))); } } while (0)
#define DIL_VLOAD(dst, T, pp_) do { const bf16_t* zr_ = zq + T.res * ZLD_O; _Pragma("unroll") for (int i = 0; i < 4; ++i) { const int key = (lane >> 3) + 8 * i; const int kjj_ = min(max(T.jj0 - 64 + 32 * (pp_) + key, 0), T.L - 1); \
            if ((pp_) == 4 && i >= 2) dst[i] = (bf16x8){0, 0, 0, 0, 0, 0, 0, 0};     \
            else dst[i] = *(const bf16x8*)(zr_ + ((unsigned)(kjj_ << T.dsh) * ZLD_O + 2048u + 8u * (lane & 7))); } } while (0)
    DilTile cur = dil_tile(wid, blk);
    bf16x8 qf[2], kst[5][4]; bf16x8 vb3[3][4];
    DIL_KQLOAD(cur); DIL_VLOAD(vb3[0], cur, 0); DIL_VLOAD(vb3[1], cur, 1);
#pragma unroll 1
    for (int it = wid; it < 48; it += 8) {
        const bool has_next = it + 8 < 48; const DilTile nxt = dil_tile(has_next ? it + 8 : it, blk);
        const int br = cur.br, dsh = cur.dsh, L = cur.L, res = cur.res, jj0 = cur.jj0;
        const int qtok = ((jj0 + fr) << dsh) + res;
        f32x4 s[10];
#pragma unroll
        for (int pq = 0; pq < 5; ++pq) {
            WAVE_SYNC();
            stage_vt(vt, kst[pq], lane);
            WAVE_SYNC();
#pragma unroll
            for (int tt = 0; tt < 2; ++tt) {
                if (pq == 4 && tt == 1) { s[9] = (f32x4){0.f, 0.f, 0.f, 0.f}; continue; }
                const bf16x8 k0 = *(const bf16x8*)(vt + (16 * tt + fr) * 80 + 8 * g), k1 = *(const bf16x8*)(vt + (16 * tt + fr) * 80 + 32 + 8 * g);
                f32x4 a = (f32x4){0.f, 0.f, 0.f, 0.f}; a = mfma16(k0, qf[0], a); a = mfma16(k1, qf[1], a); s[2 * pq + tt] = a; }
        }
        if (has_next) DIL_KQLOAD(nxt);
        const float* tbp = TB + br * 160 + (4 * g - fr + 15);
        float m = -1e30f;
#pragma unroll
        for (int kt = 0; kt < 9; ++kt)
#pragma unroll
            for (int j = 0; j < 4; ++j) s[kt][j] = s[kt][j] * (0.125f * LOG2E) + tbp[16 * kt + j];
        if (jj0 < 64 || jj0 + 80 > L) {
#pragma unroll
            for (int kt = 0; kt < 9; ++kt)
#pragma unroll
                for (int j = 0; j < 4; ++j) { const int kjj = jj0 - 64 + 16 * kt + 4 * g + j; s[kt][j] = (kjj >= 0 && kjj < L) ? s[kt][j] : -1e30f; } }
#pragma unroll
        for (int kt = 0; kt < 9; ++kt)
#pragma unroll
            for (int j = 0; j < 4; ++j) m = fmaxf(m, s[kt][j]);
        m = fmaxf(m, __shfl_xor(m, 16)); m = fmaxf(m, __shfl_xor(m, 32));
        float l = 0.f;
#pragma unroll
        for (int kt = 0; kt < 9; ++kt)
#pragma unroll
            for (int j = 0; j < 4; ++j) { const float e = __builtin_amdgcn_exp2f(s[kt][j] - m); s[kt][j] = e; l += e; }
        l += __shfl_xor(l, 16); l += __shfl_xor(l, 32);
        f32x4 o[4];
#pragma unroll
        for (int dt = 0; dt < 4; ++dt) o[dt] = (f32x4){0.f, 0.f, 0.f, 0.f};
#pragma unroll
        for (int pp = 0; pp < 5; ++pp) {
            if (pp + 2 < 5) DIL_VLOAD(vb3[(pp + 2) % 3], cur, pp + 2);
            WAVE_SYNC();
            stage_vt(vt, vb3[pp % 3], lane);
            WAVE_SYNC();
            if (pp == 3 && has_next) DIL_VLOAD(vb3[0], nxt, 0);
            if (pp == 4 && has_next) DIL_VLOAD(vb3[1], nxt, 1);
            const bf16x8 pb = pack8(s[2 * pp], s[2 * pp + 1]);
#pragma unroll
            for (int dt = 0; dt < 4; ++dt) { const bf16x8 va = read_vT(vt, dt, lane); o[dt] = mfma16(va, pb, o[dt]); }
        }
        const float inv = 1.0f / l; const int loc = qtok - blk * 256;
#pragma unroll
        for (int dt = 0; dt < 4; ++dt) { u32x2 w; w.x = cvt_pk_bf16(o[dt][0] * inv, o[dt][1] * inv); w.y = cvt_pk_bf16(o[dt][2] * inv, o[dt][3] * inv); *(u32x2*)(OB + (br * 256 + loc) * 64 + 16 * dt + 4 * g) = w; }
        if (g == 0) LSE[br * 256 + loc] = (m + __builtin_amdgcn_logf(l)) * LN2;
        cur = nxt;
    }
    __syncthreads();
    { const int tok = tid >> 1, hf = tid & 1; const float l0 = LSE[tok], l1 = LSE[256 + tok], l2 = LSE[512 + tok]; const float mx = fmaxf(l0, fmaxf(l1, l2));
      float w0 = __expf(l0 - mx), w1 = __expf(l1 - mx), w2 = __expf(l2 - mx); const float inv = 1.0f / (w0 + w1 + w2); w0 *= inv; w1 *= inv; w2 *= inv;
#pragma unroll
      for (int c = 0; c < 4; ++c) { const bf16x8 a0 = *(const bf16x8*)(OB + (0 * 256 + tok) * 64 + 32 * hf + 8 * c), a1 = *(const bf16x8*)(OB + (1 * 256 + tok) * 64 + 32 * hf + 8 * c), a2 = *(const bf16x8*)(OB + (2 * 256 + tok) * 64 + 32 * hf + 8 * c);
          float r[8];
#pragma unroll
          for (int e = 0; e < 8; ++e) r[e] = w0 * bf2f((bf16_t)a0[e]) + w1 * bf2f((bf16_t)a1[e]) + w2 * bf2f((bf16_t)a2[e]);
          u32x4 w; w.x = cvt_pk_bf16(r[0], r[1]); w.y = cvt_pk_bf16(r[2], r[3]); w.z = cvt_pk_bf16(r[4], r[5]); w.w = cvt_pk_bf16(r[6], r[7]);
          *(u32x4*)(Mx + (tokb + blk * 256 + tok) * DM + 512 + h * 64 + 32 * hf + 8 * c) = w; } }
    __syncthreads();
}

__device__ __forceinline__ void phase_odd_mix1(const Params& p, unsigned char* lds, int idx) {
    const int t_ = TID(); const int wid = __builtin_amdgcn_readfirstlane(t_ >> 6), lane = t_ & 63;
    if (!(DBG_SKIP & 4)) for (int it = BID(); it < NSEQ * 64; it += GDIM()) rg_wave<0>(p, lds + wid * RG_WAVE_LDS, idx, it >> 6, it & 63, wid, lane);
    __syncthreads();
    for (int rep = 0; rep < ((DBG_REP & 64) ? 2 : 1); ++rep)
    if (!(DBG_SKIP & 8)) for (int it = BID(); it < NSEQ * 16 * 8; it += GDIM()) dil_item(p, lds, it >> 7, (it >> 3) & 15, it & 7);
}
__device__ __forceinline__ void phase_odd_mix3(const Params& p, unsigned char* lds, int idx) {
    const int t_ = TID(); const int wid = __builtin_amdgcn_readfirstlane(t_ >> 6), lane = t_ & 63;
    if (!(DBG_SKIP & 4)) for (int it = BID(); it < NSEQ * 64; it += GDIM()) rg_wave<1>(p, lds + wid * RG_WAVE_LDS, idx, it >> 6, it & 63, wid, lane);
}

#define XB_TMO      128
#define XB_XCNT(j)  (256  + 64 * (j))
#define XB_XSUB(j)  (1280 + 64 * (j))
#define XB_XGEN(j)  (2304 + 64 * (j))
#define XB_TOP      3328
#define XB_TOPGEN   3392
#define XCD_BAR_WORDS 3456
#define XB_SPIN_CAP (1u << 22)
__device__ __forceinline__ unsigned xb_ld(unsigned* p)              { return __hip_atomic_load(p, __ATOMIC_RELAXED, __HIP_MEMORY_SCOPE_AGENT); }
__device__ __forceinline__ unsigned xb_add(unsigned* p, unsigned v) { return __hip_atomic_fetch_add(p, v, __ATOMIC_RELAXED, __HIP_MEMORY_SCOPE_AGENT); }
__device__ __forceinline__ unsigned xb_xcc_id() { return (unsigned)__builtin_amdgcn_s_getreg((3 << 11) | 20) & 0xFu; }
#define XB_SPIN(cond, bar) do { unsigned _sp = 0; while (cond) { __builtin_amdgcn_s_sleep(1); \
    if ((++_sp & 255u) == 0u) { if (xb_ld(&(bar)[XB_TMO])) break; if (_sp > XB_SPIN_CAP) { atomicAdd(&(bar)[XB_TMO], 1u); break; } } } } while (0)
struct XcdBarrier { unsigned* bar; unsigned x; volatile LAS unsigned* st; };
__device__ __forceinline__ XcdBarrier xcd_barrier_post(unsigned* bar, volatile LAS unsigned* st) {
    XcdBarrier b; b.bar = bar; b.x = xb_xcc_id(); b.st = st;
    if (threadIdx.x == 0) (void)xb_add(&bar[XB_XCNT(b.x)], 1u);
    return b;
}
__device__ __forceinline__ void xcd_barrier_complete(unsigned* bar, unsigned x, unsigned& nloc, unsigned& nx) {
    const unsigned G = gridDim.x * gridDim.y * gridDim.z;
    unsigned sum, cnt, mine, sp = 0u;
    for (;;) {
        sum = 0u; cnt = 0u; mine = 0u;
#pragma unroll
        for (unsigned j = 0; j < 16; ++j) { const unsigned c = xb_ld(&bar[XB_XCNT(j)]); sum += c; cnt += (c > 0u) ? 1u : 0u; mine = (j == x) ? c : mine; }
        if (sum == G) break;
        __builtin_amdgcn_s_sleep(1);
        if ((++sp & 255u) == 0u) { if (xb_ld(&bar[XB_TMO])) break; if (sp > XB_SPIN_CAP) { atomicAdd(&bar[XB_TMO], 1u); break; } }
    }
    nloc = mine > 0u ? mine : 1u; nx = cnt > 0u ? cnt : 1u;
}
__device__ __forceinline__ void xcd_barrier(const XcdBarrier& b) {
    asm volatile("s_waitcnt vmcnt(0)" ::: "memory");
    __syncthreads();
    if (threadIdx.x == 0) {
        unsigned* bar = b.bar;
        __builtin_amdgcn_s_waitcnt(0);
        unsigned nloc = b.st[0], nx = b.st[1];
        if (nloc == 0u) { xcd_barrier_complete(bar, b.x, nloc, nx); b.st[0] = nloc; b.st[1] = nx; }
        const unsigned old = xb_add(&bar[XB_XSUB(b.x)], 1u);
        const unsigned gen = old / nloc;
        if (old + 1u == (gen + 1u) * nloc) {
            __builtin_amdgcn_fence(__ATOMIC_RELEASE, "agent");
            asm volatile("s_waitcnt vmcnt(0)" ::: "memory");
            const unsigned og = xb_add(&bar[XB_TOP], 1u);
            const unsigned tg = og / nx;
            if (og + 1u == (tg + 1u) * nx) xb_add(&bar[XB_TOPGEN], 1u);
            else XB_SPIN(xb_ld(&bar[XB_TOPGEN]) == tg, bar);
            __builtin_amdgcn_fence(__ATOMIC_ACQUIRE, "agent");
            xb_add(&bar[XB_XGEN(b.x)], 1u);
            asm volatile("s_waitcnt vmcnt(0)" ::: "memory");
        } else {
            XB_SPIN(xb_ld(&bar[XB_XGEN(b.x)]) == gen, bar);
            __builtin_amdgcn_fence(__ATOMIC_ACQUIRE, "agent");
            asm volatile("s_waitcnt vmcnt(0)" ::: "memory");
        }
    }
    __syncthreads();
}

constexpr int N_PHASES = 35;
__device__ __forceinline__ void run_phase(const Params& p, unsigned char* lds, int ph) {
    if (ph == 0) { phase_prep(p, lds); return; }
    const int q = ph - 1; int layer, k;
    if (q < 8) { layer = 0; k = q; } else if (q < 17) { layer = 1; k = q - 8; } else if (q < 25) { layer = 2; k = q - 17; } else { layer = 3; k = q - 25; }
    const int idx = layer >> 1;
    if ((layer & 1) == 0) {
        if (k == 0) phase_gemm(p, lds, layer, 0);
        else if (k == 1) { if (!(DBG_SKIP & 1)) phase_even_mix(p, lds, idx); if (DBG_REP & 1) { __syncthreads(); phase_even_mix(p, lds, idx); } }
        else if (k == 2) { if (!(DBG_SKIP & 1)) phase_hgrn_fin(p, idx); }
        else if (k == 3) phase_gemm(p, lds, layer, 1);
        else if (k == 4) phase_rowpass(p, layer, 0);
        else if (k == 5) phase_gemm(p, lds, layer, 2);
        else if (k == 6) phase_gemm(p, lds, layer, 3);
        else phase_rowpass(p, layer, 1);
    } else {
        if (k == 0) phase_gemm(p, lds, layer, 0);
        else if (k == 1) { if (!(DBG_SKIP & 2)) phase_odd_mix1(p, lds, idx); if (DBG_REP & 2) { __syncthreads(); phase_odd_mix1(p, lds, idx); } }
        else if (k == 2) { if (!(DBG_SKIP & 2)) phase_rg_carry(p); }
        else if (k == 3) { if (!(DBG_SKIP & 2)) phase_odd_mix3(p, lds, idx); if (DBG_REP & 4) { __syncthreads(); phase_odd_mix3(p, lds, idx); } }
        else if (k == 4) phase_gemm(p, lds, layer, 1);
        else if (k == 5) phase_rowpass(p, layer, 0);
        else if (k == 6) phase_gemm(p, lds, layer, 2);
        else if (k == 7) phase_gemm(p, lds, layer, 3);
        else phase_rowpass(p, layer, 1);
    }
}

__global__ void __launch_bounds__(512, 2) fwd_kernel(Params p) {
    extern __shared__ __attribute__((aligned(16))) unsigned char lds[];
    cg::grid_group grid = cg::this_grid();
    volatile LAS unsigned* st = (volatile LAS unsigned*)(lds + LDS_BYTES - 16);
    if (threadIdx.x < 4) st[threadIdx.x] = 0u;
    __syncthreads();
    const XcdBarrier bar = xcd_barrier_post((unsigned*)(p.ws + WS_CTL) + 256, st);
    for (int ph = p.ph_lo; ph < p.ph_hi; ++ph) {
        if (ph == p.ph_lo + 1) grid.sync();
        else if (ph > p.ph_lo) xcd_barrier(bar);
        run_phase(p, lds, ph);
    }
}

extern "C" void kernel_launch(void* const* d_in, const int* in_sizes, int n_in, void* d_out, int out_size, void* d_ws, size_t ws_size, hipStream_t stream) {
    static int grid = 0;
    if (grid == 0) {
        if (n_in != 21 || ws_size < WS_RS + (size_t)NTOK * 4) { fprintf(stderr, "kernel_launch: unexpected n_in %d / ws_size %zu (need %zu)\n", n_in, ws_size, (size_t)WS_END); grid = -1; return; }
        int dev = 0, cus = 0, per_cu = 0;
        (void)hipGetDevice(&dev); (void)hipDeviceGetAttribute(&cus, hipDeviceAttributeMultiprocessorCount, dev);
        if (hipFuncSetAttribute((const void*)fwd_kernel, hipFuncAttributeMaxDynamicSharedMemorySize, LDS_BYTES) != hipSuccess) { fprintf(stderr, "kernel_launch: hipFuncSetAttribute failed\n"); grid = -1; return; }
        if (hipOccupancyMaxActiveBlocksPerMultiprocessor(&per_cu, (const void*)fwd_kernel, NTHR, LDS_BYTES) != hipSuccess || per_cu < 1) { fprintf(stderr, "kernel_launch: occupancy query says %d\n", per_cu); per_cu = 1; }
        (void)hipGetLastError();
        grid = cus > 0 ? cus : 256;
    }
    if (grid < 0) return;
    if (hipMemsetAsync((char*)d_ws + WS_CTL, 0, CTL_BYTES, stream) != hipSuccess) { fprintf(stderr, "kernel_launch: memset of the control words failed\n"); return; }
    Params p{};
    for (int i = 0; i < 21; ++i) p.in[i] = (const float*)d_in[i];
    p.out = (float*)d_out; p.ws = (unsigned char*)d_ws;
#if MK_MULTI_LAUNCH
    for (int ph = 0; ph < N_PHASES; ++ph) { p.ph_lo = ph; p.ph_hi = ph + 1; hipLaunchKernelGGL(fwd_kernel, dim3(grid), dim3(NTHR), LDS_BYTES, stream, p); }
#else
    p.ph_lo = 0; p.ph_hi = N_PHASES;
    void* args[] = {&p};
    hipError_t e = hipLaunchCooperativeKernel((const void*)fwd_kernel, dim3(grid), dim3(NTHR), args, LDS_BYTES, stream);
    if (e != hipSuccess) fprintf(stderr, "kernel_launch: cooperative launch failed: %s (grid %d)\n", hipGetErrorString(e), grid);
#endif
}
```

```cpp
#include <hip/hip_runtime.h>
#include <hip/hip_cooperative_groups.h>
#include <cstdio>
namespace cg = cooperative_groups;

#ifndef DBG_SKIP
#define DBG_SKIP 0
#endif
#ifndef DBG_REP
#define DBG_REP 0
#endif
#ifndef MK_MULTI_LAUNCH
#define MK_MULTI_LAUNCH 0
#endif

#define LAS __attribute__((address_space(3)))
typedef unsigned short bf16_t;
typedef short bf16x8 __attribute__((ext_vector_type(8)));
typedef short bf16x4 __attribute__((ext_vector_type(4)));
typedef float f32x4 __attribute__((ext_vector_type(4)));
typedef unsigned u32x4 __attribute__((ext_vector_type(4)));
typedef unsigned u32x2 __attribute__((ext_vector_type(2)));
typedef unsigned short us2_t __attribute__((ext_vector_type(2)));

constexpr int DM = 1024, SEQ = 4096, NSEQ = 20, NTOK = NSEQ * SEQ, MIXW = 512, DFF = 2816;
constexpr int ZLD_E = 4096, ZLD_O = 2560;
constexpr int NTHR = 512;
constexpr int LDS_BYTES = 156 * 1024;

constexpr size_t LW_WIN = 0, LW_WOUT = (size_t)4096 * 1024 * 2, LW_WGU = LW_WOUT + (size_t)1024 * 1024 * 2,
                 LW_WD = LW_WGU + (size_t)5632 * 1024 * 2, LW_STRIDE = LW_WD + (size_t)1024 * 2816 * 2;
constexpr size_t WS_CTL = 0, CTL_BYTES = 32768, WS_W = CTL_BYTES, WS_RGW = WS_W + 4 * LW_STRIDE, WS_RGS = WS_RGW + (size_t)2 * 131072 * 2;
constexpr size_t RGS_ONE = (size_t)NSEQ * 64 * 2 * 512 * 4;
constexpr size_t WS_HB = WS_RGS + 3 * RGS_ONE, WS_HGB = WS_HB + (size_t)NTOK * 1024 * 2, WS_BIG = WS_HGB + (size_t)NTOK * 512 * 2,
                 WS_END = WS_BIG + (size_t)NTOK * 4096 * 2;
constexpr size_t BIG_Y = (size_t)NTOK * DFF * 2;
constexpr size_t WS_RS = WS_END;
static_assert(WS_RS + (size_t)NTOK * 4 <= (size_t)1073741824, "workspace");
static_assert(BIG_Y + (size_t)NTOK * 1024 * 2 <= (size_t)NTOK * 4096 * 2, "Y fits");

struct Params {
    const float* in[21];
    float* out;
    unsigned char* ws;
    int ph_lo, ph_hi;
};

__device__ __forceinline__ float bf2f(bf16_t b) { return __uint_as_float(((unsigned)b) << 16); }
typedef __bf16 bf16v2_t __attribute__((ext_vector_type(2)));
typedef float f32x2 __attribute__((ext_vector_type(2)));
__device__ __forceinline__ unsigned cvt_pk_bf16(float lo, float hi) { const f32x2 v = {lo, hi}; const bf16v2_t b = __builtin_convertvector(v, bf16v2_t); return __builtin_bit_cast(unsigned, b); }
__device__ __forceinline__ bf16_t f2bf(float f) { return (bf16_t)(cvt_pk_bf16(f, 0.f) & 0xffffu); }
__device__ __forceinline__ bf16x8 pack8(f32x4 a, f32x4 b) {
    u32x4 w; w.x = cvt_pk_bf16(a[0], a[1]); w.y = cvt_pk_bf16(a[2], a[3]); w.z = cvt_pk_bf16(b[0], b[1]); w.w = cvt_pk_bf16(b[2], b[3]);
    return __builtin_bit_cast(bf16x8, w);
}
__device__ __forceinline__ f32x4 mfma16(bf16x8 a, bf16x8 b, f32x4 c) { return __builtin_amdgcn_mfma_f32_16x16x32_bf16(a, b, c, 0, 0, 0); }
#define WAVE_SYNC() asm volatile("s_waitcnt lgkmcnt(0)" ::: "memory")
__device__ __forceinline__ float fexp(float x) { return __builtin_amdgcn_exp2f(x * 1.44269504f); }
__device__ __forceinline__ float flog(float x) { return __builtin_amdgcn_logf(x) * 0.69314718f; }
__device__ __forceinline__ float sigmoidf_(float x) { return __builtin_amdgcn_rcpf(1.0f + fexp(-x)); }
__device__ __forceinline__ float siluf_(float x) { return x * sigmoidf_(x); }
__device__ __forceinline__ float wave_sum(float v) {
#pragma unroll
    for (int o = 32; o > 0; o >>= 1) v += __shfl_xor(v, o);
    return v;
}

__device__ __forceinline__ int TID() { int t = threadIdx.x; asm volatile("" : "+v"(t)); return t; }
__device__ __forceinline__ int BID() { int t = blockIdx.x; asm volatile("" : "+s"(t)); return t; }
__device__ __forceinline__ int GDIM() { int t = gridDim.x; asm volatile("" : "+s"(t)); return t; }

__constant__ unsigned char T5_BUCKET[3 * 129] = {
11,11,11,11,11,11,11,11,11,11,11,11,11,11,11,10,10,10,10,10,10,10,10,10,10,10,10,10,10,10,10,10,10,10,10,10,10,10,9,9,9,9,9,9,9,9,9,9,9,9,8,8,8,8,8,8,8,7,6,5,4,3,2,1,0,17,18,19,20,21,22,23,24,24,24,24,24,24,24,25,25,25,25,25,25,25,25,25,25,25,25,26,26,26,26,26,26,26,26,26,26,26,26,26,26,26,26,26,26,26,26,26,26,26,27,27,27,27,27,27,27,27,27,27,27,27,27,27,27,
13,13,13,13,13,13,13,13,13,13,13,13,13,13,13,13,13,13,13,13,13,13,13,12,12,12,12,12,12,12,12,12,12,12,12,12,12,12,12,12,12,12,11,11,11,11,11,11,11,11,11,11,10,10,10,10,10,10,9,9,9,8,8,4,0,20,24,24,25,25,25,26,26,26,26,26,26,27,27,27,27,27,27,27,27,27,27,28,28,28,28,28,28,28,28,28,28,28,28,28,28,28,28,28,28,28,29,29,29,29,29,29,29,29,29,29,29,29,29,29,29,29,29,29,29,29,29,29,29,
15,15,15,15,15,15,15,15,15,15,15,15,15,15,15,15,15,15,15,15,15,15,15,15,15,15,15,15,15,15,14,14,14,14,14,14,14,14,14,14,14,14,14,14,14,13,13,13,13,13,13,13,13,13,12,12,12,12,12,11,11,10,10,9,0,25,26,26,27,27,28,28,28,28,28,29,29,29,29,29,29,29,29,29,30,30,30,30,30,30,30,30,30,30,30,30,30,30,30,31,31,31,31,31,31,31,31,31,31,31,31,31,31,31,31,31,31,31,31,31,31,31,31,31,31,31,31,31,31};

namespace pg8 {
constexpr int BM = 256, BK = 64, HALF = 128, HTB = HALF * BK * 2, STAGE_BYTES = 8 * HTB, NXCD = 8, WGM = 8;
__device__ __forceinline__ int lds_byte(int r, int c) { const int st = (r >> 4) * 2 + (c >> 5), rr = r & 15, cc = c & 31, ob = rr * 64 + cc * 2; return st * 1024 + (ob ^ (((ob >> 9) & 1) << 5)); }
__device__ __forceinline__ void stage_rc(int b, int& R, int& C) { const int st = b / 1024, sb = b % 1024, swz = sb ^ (((sb >> 9) & 1) << 5); R = (st >> 1) * 16 + swz / 64; C = (st & 1) * 32 + (swz % 64) / 2; }
__device__ __forceinline__ int perm32(int rho) { const int n = rho >> 4, i = rho & 15; return 8 * (i >> 2) + 4 * n + (i & 3); }
struct Unit { int pm, pn; };
struct Gemm { const bf16_t* A; const bf16_t* Bt; int M, N, K; };
struct StaticOrder {
    int nM, nN, nwg, G, c;
    __device__ __forceinline__ void init(int M, int N, int G_, int c_) { nM = M / BM; nN = N / BM; nwg = nM * nN; G = G_; c = c_; }
    __device__ bool next(int i, Unit& u) const {
        const long L = (long)i * G + c; if (L >= nwg) return false;
        int wgid = (int)L; { const int q = nwg / NXCD, r = nwg % NXCD, xcd = wgid % NXCD, off = wgid / NXCD; wgid = (xcd < r ? xcd * (q + 1) : r * (q + 1) + (xcd - r) * q) + off; }
        const int nig = WGM * nN, gid = wgid / nig, fm = gid * WGM, gsz = (nM - fm) < WGM ? (nM - fm) : WGM;
        u.pm = fm + ((wgid % nig) % gsz); u.pn = (wgid % nig) / gsz; return true;
    }
};
struct EpiStore {
    bf16_t* O; int ldc; const float* rs;
    __device__ __forceinline__ void operator()(const f32x4 (&acc)[2][2][4][2], const Unit& u, int wr, int wc, int fr, int fq) const {
        const int row0 = u.pm * BM + wr * 64 + fr; const int col0 = u.pn * BM + wc * 32 + 8 * fq;
#pragma unroll
        for (int ai = 0; ai < 2; ++ai)
#pragma unroll
            for (int m = 0; m < 4; ++m) { const int row = row0 + ai * HALF + m * 16; bf16_t* rowp = O + (size_t)row * ldc + col0; const float sc = rs ? rs[row] : 1.0f;
#pragma unroll
                for (int bj = 0; bj < 2; ++bj) { const f32x4 v0 = acc[ai][bj][m][0] * sc, v1 = acc[ai][bj][m][1] * sc;
                    u32x4 w; w.x = cvt_pk_bf16(v0[0], v0[1]); w.y = cvt_pk_bf16(v0[2], v0[3]); w.z = cvt_pk_bf16(v1[0], v1[1]); w.w = cvt_pk_bf16(v1[2], v1[3]);
                    *(u32x4*)(rowp + bj * HALF) = w; } }
    }
};
struct EpiSwiGLU {
    bf16_t* O; int ldc; const float* rs;
    __device__ __forceinline__ void operator()(const f32x4 (&acc)[2][2][4][2], const Unit& u, int wr, int wc, int fr, int fq) const {
        const int row0 = u.pm * BM + wr * 64 + fr; const int col0 = u.pn * HALF + wc * 32 + 8 * fq;
#pragma unroll
        for (int ai = 0; ai < 2; ++ai)
#pragma unroll
            for (int m = 0; m < 4; ++m) { const int row = row0 + ai * HALF + m * 16; bf16_t* rowp = O + (size_t)row * ldc + col0; const float sc = rs[row]; const float sc2 = sc * sc, scl = sc * -1.44269504f;
                f32x4 v0, v1;
#pragma unroll
                for (int j = 0; j < 4; ++j) {
                    const float g0 = acc[ai][0][m][0][j], g1 = acc[ai][0][m][1][j];
                    v0[j] = (g0 * acc[ai][1][m][0][j]) * (sc2 * __builtin_amdgcn_rcpf(1.0f + __builtin_amdgcn_exp2f(g0 * scl)));
                    v1[j] = (g1 * acc[ai][1][m][1][j]) * (sc2 * __builtin_amdgcn_rcpf(1.0f + __builtin_amdgcn_exp2f(g1 * scl))); }
                u32x4 w; w.x = cvt_pk_bf16(v0[0], v0[1]); w.y = cvt_pk_bf16(v0[2], v0[3]); w.z = cvt_pk_bf16(v1[0], v1[1]); w.w = cvt_pk_bf16(v1[2], v1[3]);
                *(u32x4*)rowp = w; }
    }
};

template <class Epi>
__device__ __forceinline__ void gemm_phase(LAS unsigned char* lds, const Gemm g, const StaticOrder& S, const Epi& E) {
    const int tid = TID(), wid = __builtin_amdgcn_readfirstlane(tid >> 6), lane = tid & 63, wr = wid >> 2, wc = wid & 3, fr = lane & 15, fq = lane >> 4;
    const int K = g.K, nt = K / BK;
    unsigned voffA[2], voffB[2];
#pragma unroll
    for (int i = 0; i < 2; ++i) { int R, C; stage_rc(tid * 16 + i * 8192, R, C); const int Rb = (R & ~31) + perm32(R & 31);
        voffA[i] = (unsigned)(R * K + C) * 2u; voffB[i] = (unsigned)(Rb * K + C) * 2u; }
    const size_t kstep = (size_t)(BK * 2);
    const size_t hstep = (size_t)HALF * K * 2;
    const size_t tstep = 2 * hstep;
    const unsigned ldsw = (unsigned)wid * 1024u;
    const int aoff = lds_byte(wr * 64 + fr, fq * 8), boff = lds_byte(wc * 32 + fr, fq * 8);
#define PG8_SA(b, h) (((b) * 2 + (h)) * HTB)
#define PG8_SB(b, h) ((4 + (b) * 2 + (h)) * HTB)
#define PG8_STAGE(bufoff, gbase, voff) do { _Pragma("unroll") for (int _i = 0; _i < 2; ++_i) \
        __builtin_amdgcn_global_load_lds((const unsigned*)((const char*)(gbase) + (voff)[_i]), (LAS unsigned*)(lds + (bufoff) + ldsw + _i * 8192), 16, 0, 0); } while (0)
#define PG8_LDA(dst, b, h) do { _Pragma("unroll") for (int m = 0; m < 4; ++m) _Pragma("unroll") for (int k = 0; k < 2; ++k) dst[m][k] = *(const LAS bf16x8*)(lds + PG8_SA(b, h) + aoff + m * 2048 + k * 1024); } while (0)
#define PG8_LDB(dst, b, h) do { _Pragma("unroll") for (int n = 0; n < 2; ++n) _Pragma("unroll") for (int k = 0; k < 2; ++k) dst[n][k] = *(const LAS bf16x8*)(lds + PG8_SB(b, h) + boff + n * 2048 + k * 1024); } while (0)
#define PG8_MMA(ai, bj, At, Bt) do { __builtin_amdgcn_s_setprio(1); _Pragma("unroll") for (int m = 0; m < 4; ++m) _Pragma("unroll") for (int n = 0; n < 2; ++n) _Pragma("unroll") for (int k = 0; k < 2; ++k) \
        acc[ai][bj][m][n] = __builtin_amdgcn_mfma_f32_16x16x32_bf16(Bt[n][k], At[m][k], acc[ai][bj][m][n], 0, 0, 0); __builtin_amdgcn_s_setprio(0); } while (0)
#define PG8_WAIT_V(n) asm volatile("s_waitcnt vmcnt(" #n ")" ::: "memory")
#define PG8_WAIT_L(n) asm volatile("s_waitcnt lgkmcnt(" #n ")" ::: "memory")
#define PG8_BAR __builtin_amdgcn_s_barrier()
#define PG8_SCHED __builtin_amdgcn_sched_barrier(0)
    Unit cur, nxt; int ui = 0;
    if (!S.next(0, cur)) return;
    f32x4 acc[2][2][4][2];
#pragma unroll
    for (int a = 0; a < 2; ++a)
#pragma unroll
        for (int b = 0; b < 2; ++b)
#pragma unroll
            for (int m = 0; m < 4; ++m)
#pragma unroll
                for (int n = 0; n < 2; ++n) acc[a][b][m][n] = (f32x4){0.f, 0.f, 0.f, 0.f};
    bf16x8 At[4][2], B0[2][2], B1[2][2];
    const char* cA = (const char*)g.A + (size_t)cur.pm * tstep; const char* cB = (const char*)g.Bt + (size_t)cur.pn * tstep;
    PG8_STAGE(PG8_SB(0, 0), cB, voffB); PG8_STAGE(PG8_SB(0, 1), cB + hstep, voffB); PG8_STAGE(PG8_SA(0, 0), cA, voffA); PG8_STAGE(PG8_SA(0, 1), cA + hstep, voffA);
    if (wr == 1) PG8_BAR;
    PG8_WAIT_V(2); PG8_BAR;
    PG8_STAGE(PG8_SB(1, 0), cB + kstep, voffB); PG8_STAGE(PG8_SA(1, 0), cA + kstep, voffA); PG8_STAGE(PG8_SB(1, 1), cB + hstep + kstep, voffB);
    PG8_WAIT_V(6); PG8_BAR;
    for (;;) {
        const bool has_next = S.next(ui + 1, nxt);
        const char* nA = has_next ? (const char*)g.A + (size_t)nxt.pm * tstep : cA; const char* nB = has_next ? (const char*)g.Bt + (size_t)nxt.pn * tstep : cB;
        for (int t = 0; t < nt; t += 2) {
            const bool last = (t == nt - 2);
            const char* a1 = cA + (size_t)(t + 1) * kstep;
            const char* a2 = last ? nA : cA + (size_t)(t + 2) * kstep; const char* b2 = last ? nB : cB + (size_t)(t + 2) * kstep;
            const char* a3 = a2 + kstep; const char* b3 = b2 + kstep;
            PG8_LDB(B0, 0, 0); PG8_LDB(B1, 0, 1); PG8_SCHED; PG8_LDA(At, 0, 0); PG8_STAGE(PG8_SA(1, 1), a1 + hstep, voffA);
            PG8_WAIT_V(8); PG8_WAIT_L(0); PG8_BAR; PG8_MMA(0, 0, At, B0); PG8_MMA(0, 1, At, B1); PG8_BAR; PG8_SCHED;
            PG8_LDA(At, 0, 1); PG8_STAGE(PG8_SB(0, 0), b2, voffB); PG8_STAGE(PG8_SB(0, 1), b2 + hstep, voffB); PG8_STAGE(PG8_SA(0, 0), a2, voffA);
            PG8_WAIT_V(8); PG8_WAIT_L(0); PG8_BAR; PG8_MMA(1, 0, At, B0); PG8_MMA(1, 1, At, B1); PG8_BAR; PG8_SCHED;
            PG8_LDB(B0, 1, 0); PG8_LDB(B1, 1, 1); PG8_SCHED; PG8_LDA(At, 1, 0); PG8_STAGE(PG8_SA(0, 1), a2 + hstep, voffA);
            PG8_WAIT_V(8); PG8_WAIT_L(0); PG8_BAR; PG8_MMA(0, 0, At, B0); PG8_MMA(0, 1, At, B1); PG8_BAR; PG8_SCHED;
            PG8_LDA(At, 1, 1); PG8_STAGE(PG8_SB(1, 0), b3, voffB); PG8_STAGE(PG8_SB(1, 1), b3 + hstep, voffB); PG8_STAGE(PG8_SA(1, 0), a3, voffA);
            PG8_WAIT_V(8); PG8_WAIT_L(0); PG8_BAR; PG8_MMA(1, 0, At, B0); PG8_MMA(1, 1, At, B1); PG8_BAR; PG8_SCHED;
        }
        if (wr == 0) PG8_BAR;
        E(acc, cur, wr, wc, fr, fq);
        if (!has_next) break;
#pragma unroll
        for (int a = 0; a < 2; ++a)
#pragma unroll
            for (int b = 0; b < 2; ++b)
#pragma unroll
                for (int m = 0; m < 4; ++m)
#pragma unroll
                    for (int n = 0; n < 2; ++n) acc[a][b][m][n] = (f32x4){0.f, 0.f, 0.f, 0.f};
        cur = nxt; cA = nA; cB = nB; ++ui;
        if (wr == 1) PG8_BAR;
    }
    PG8_WAIT_V(0);
    PG8_BAR;
#undef PG8_SA
#undef PG8_SB
#undef PG8_STAGE
#undef PG8_LDA
#undef PG8_LDB
#undef PG8_MMA
#undef PG8_WAIT_V
#undef PG8_WAIT_L
#undef PG8_BAR
#undef PG8_SCHED
}
}

__device__ __forceinline__ bf16_t* ws_w(const Params& p, int l, size_t off) { return (bf16_t*)(p.ws + WS_W + (size_t)l * LW_STRIDE + off); }
__device__ __forceinline__ bf16_t* ws_hb(const Params& p) { return (bf16_t*)(p.ws + WS_HB); }
__device__ __forceinline__ bf16_t* ws_mx(const Params& p) { return (bf16_t*)p.out; }
__device__ __forceinline__ float* ws_rs(const Params& p) { return (float*)(p.ws + WS_RS); }
__device__ __forceinline__ bf16_t* ws_big(const Params& p) { return (bf16_t*)(p.ws + WS_BIG); }
__device__ __forceinline__ bf16_t* ws_y(const Params& p) { return (bf16_t*)(p.ws + WS_BIG + BIG_Y); }
__device__ __forceinline__ bf16_t* ws_hgb(const Params& p) { return (bf16_t*)(p.ws + WS_HGB); }
__device__ __forceinline__ const float* xin_row(const Params& p, int row) { return row < 16 * SEQ ? p.in[0] + (size_t)row * DM : p.in[1] + (size_t)(row - 16 * SEQ) * DM; }

__device__ __forceinline__ void transpose_tile(const float* W, int N, int k0, int n0, bf16_t* Wt, int ldk, int nrow0, const float* gk, float* tile  ) {
    const int tid = TID();
#pragma unroll
    for (int i = 0; i < 2; ++i) { const int r = (tid >> 4) + 32 * i, c4 = (tid & 15) * 4;
        const f32x4 v = *(const f32x4*)(W + (size_t)(k0 + r) * N + n0 + c4); const float s = gk ? gk[k0 + r] : 1.0f;
        tile[r * 65 + c4 + 0] = v[0] * s; tile[r * 65 + c4 + 1] = v[1] * s; tile[r * 65 + c4 + 2] = v[2] * s; tile[r * 65 + c4 + 3] = v[3] * s; }
    __syncthreads();
    { const int n = tid >> 3, k8 = (tid & 7) * 8; u32x4 w;
      w.x = cvt_pk_bf16(tile[(k8 + 0) * 65 + n], tile[(k8 + 1) * 65 + n]); w.y = cvt_pk_bf16(tile[(k8 + 2) * 65 + n], tile[(k8 + 3) * 65 + n]);
      w.z = cvt_pk_bf16(tile[(k8 + 4) * 65 + n], tile[(k8 + 5) * 65 + n]); w.w = cvt_pk_bf16(tile[(k8 + 6) * 65 + n], tile[(k8 + 7) * 65 + n]);
      *(u32x4*)(Wt + (size_t)(nrow0 + n) * ldk + k0 + k8) = w; }
    __syncthreads();
}

__device__ __forceinline__ void phase_prep(const Params& p, unsigned char* lds) {
    float* tile = (float*)lds;
    const int tid = TID();
    int base = 0;
    for (int l = 0; l < 4; ++l) {
        const int idx = l >> 1; const bool even = (l & 1) == 0;
        for (int m = 0; m < 5; ++m) {
            const float* src; int K = 1024, N = 1024; const float* gk = nullptr; size_t dst = 0; int mode = 0;
            if (m == 0) { N = even ? 4096 : 2560; src = even ? p.in[3] + (size_t)idx * 1024 * 4096 : p.in[8] + (size_t)idx * 1024 * 2560; gk = p.in[2] + (l * 4 + 0) * 1024; dst = LW_WIN; }
            else if (m == 1) { src = even ? p.in[4] + (size_t)idx * 1024 * 1024 : p.in[9] + (size_t)idx * 1024 * 1024; dst = LW_WOUT; }
            else if (m == 2) { N = DFF; src = p.in[18] + (size_t)l * 1024 * DFF; gk = p.in[2] + (l * 4 + 2) * 1024; dst = LW_WGU; mode = 1; }
            else if (m == 3) { N = DFF; src = p.in[19] + (size_t)l * 1024 * DFF; gk = p.in[2] + (l * 4 + 2) * 1024; dst = LW_WGU; mode = 2; }
            else { K = DFF; src = p.in[20] + (size_t)l * DFF * 1024; dst = LW_WD; }
            const int nkt = K / 64, nnt = N / 64, ntile = nkt * nnt;
            int first = BID() - (base % GDIM()); if (first < 0) first += GDIM();
            for (int t = first; t < ntile; t += GDIM()) {
                const int kt = t % nkt, ntl = t / nkt; const int n0 = ntl * 64;
                int nrow0 = n0; if (mode) nrow0 = (n0 / 128) * 256 + (n0 % 128) + (mode == 2 ? 128 : 0);
                transpose_tile(src, N, kt * 64, n0, ws_w(p, l, dst), K, nrow0, gk, tile);
            }
            base += ntile;
        }
    }
    { bf16_t* rgw = (bf16_t*)(p.ws + WS_RGW);
      for (int e = BID() * NTHR + tid; e < 2 * 2 * 2 * 8 * 4096; e += GDIM() * NTHR) {
          const int c = e & 63, d = (e >> 6) & 63, blk = (e >> 12) & 7, ax = (e >> 15) & 1, dir = (e >> 16) & 1, idx = e >> 17;
          const float* src = ax ? p.in[14] : p.in[12];
          rgw[e] = f2bf(src[(((size_t)(idx * 2 + dir) * 8 + blk) * 64 + c) * 64 + d] * -1.44269504f); } }
    { const int wid = tid >> 6, lane = tid & 63; bf16_t* hb = ws_hb(p); float* rsv = ws_rs(p);
      for (int row = BID() * 8 + wid; row < NTOK; row += GDIM() * 8) {
          const float* xr = xin_row(p, row); f32x4 v[4]; float ss = 0.f;
#pragma unroll
          for (int i = 0; i < 4; ++i) { v[i] = *(const f32x4*)(xr + i * 256 + lane * 4); ss += v[i][0] * v[i][0] + v[i][1] * v[i][1] + v[i][2] * v[i][2] + v[i][3] * v[i][3]; }
          ss = wave_sum(ss); if (lane == 0) rsv[row] = rsqrtf(ss * (1.0f / 1024.0f) + 1e-6f);
#pragma unroll
          for (int i = 0; i < 4; ++i) { u32x2 w; w.x = cvt_pk_bf16(v[i][0], v[i][1]); w.y = cvt_pk_bf16(v[i][2], v[i][3]); *(u32x2*)(hb + (size_t)row * DM + i * 256 + lane * 4) = w; } } }
}

__device__ __forceinline__ void phase_rowpass(const Params& p, int layer, int which  ) {
    const int tid = TID(), wid = tid >> 6, lane = tid & 63;
    const bf16_t* Y = ws_y(p); bf16_t* xb = ws_hb(p); float* rsv = ws_rs(p);
    const float* gp = p.in[2] + (layer * 4 + (which ? 3 : 1)) * 1024;
    const bool last = (layer == 3 && which == 1);
    float gv[2][8];
#pragma unroll
    for (int i = 0; i < 2; ++i)
#pragma unroll
        for (int e = 0; e < 8; ++e) gv[i][e] = gp[i * 512 + lane * 8 + e];
    for (int row = BID() * 8 + wid; row < NTOK; row += GDIM() * 8) {
        float xv[2][8], yv[2][8]; float ssy = 0.f;
#pragma unroll
        for (int i = 0; i < 2; ++i) { const bf16x8 xw = *(const bf16x8*)(xb + (size_t)row * DM + i * 512 + lane * 8), yw = *(const bf16x8*)(Y + (size_t)row * DM + i * 512 + lane * 8);
#pragma unroll
            for (int e = 0; e < 8; ++e) { xv[i][e] = bf2f((bf16_t)xw[e]); yv[i][e] = bf2f((bf16_t)yw[e]); ssy += yv[i][e] * yv[i][e]; } }
        ssy = wave_sum(ssy); const float rsy = rsqrtf(ssy * (1.0f / 1024.0f) + 1e-6f);
        float ssx = 0.f;
#pragma unroll
        for (int i = 0; i < 2; ++i)
#pragma unroll
            for (int e = 0; e < 8; ++e) { xv[i][e] = xv[i][e] + yv[i][e] * rsy * gv[i][e]; ssx += xv[i][e] * xv[i][e]; }
        if (last) {
#pragma unroll
            for (int i = 0; i < 2; ++i) { float* op = p.out + (size_t)row * DM + i * 512 + lane * 8;
                *(f32x4*)op = (f32x4){xv[i][0], xv[i][1], xv[i][2], xv[i][3]}; *(f32x4*)(op + 4) = (f32x4){xv[i][4], xv[i][5], xv[i][6], xv[i][7]}; }
        } else {
            ssx = wave_sum(ssx); if (lane == 0) rsv[row] = rsqrtf(ssx * (1.0f / 1024.0f) + 1e-6f);
#pragma unroll
            for (int i = 0; i < 2; ++i) { u32x4 w; w.x = cvt_pk_bf16(xv[i][0], xv[i][1]); w.y = cvt_pk_bf16(xv[i][2], xv[i][3]); w.z = cvt_pk_bf16(xv[i][4], xv[i][5]); w.w = cvt_pk_bf16(xv[i][6], xv[i][7]);
                *(u32x4*)(xb + (size_t)row * DM + i * 512 + lane * 8) = w; }
        }
    }
}

__device__ __forceinline__ void phase_gemm(const Params& p, unsigned char* lds, int layer, int which  ) {
    const bool even = (layer & 1) == 0;
    pg8::Gemm g; g.M = NTOK; pg8::StaticOrder S;
    LAS unsigned char* l3 = (LAS unsigned char*)lds;
    if (which == 2) { g.A = ws_hb(p); g.Bt = ws_w(p, layer, LW_WGU); g.N = 2 * DFF; g.K = 1024; S.init(g.M, g.N, GDIM(), BID());
        pg8::EpiSwiGLU E{ws_big(p), DFF, ws_rs(p)}; pg8::gemm_phase(l3, g, S, E); }
    else { pg8::EpiStore E;
        if (which == 0) { g.A = ws_hb(p); g.Bt = ws_w(p, layer, LW_WIN); g.N = even ? ZLD_E : ZLD_O; g.K = 1024; E.O = ws_big(p); E.ldc = g.N; E.rs = ws_rs(p); }
        else if (which == 1) { g.A = ws_mx(p); g.Bt = ws_w(p, layer, LW_WOUT); g.N = 1024; g.K = 1024; E.O = ws_y(p); E.ldc = 1024; E.rs = nullptr; }
        else { g.A = ws_big(p); g.Bt = ws_w(p, layer, LW_WD); g.N = 1024; g.K = DFF; E.O = ws_y(p); E.ldc = 1024; E.rs = nullptr; }
        S.init(g.M, g.N, GDIM(), BID()); pg8::gemm_phase(l3, g, S, E); }
}

__device__ __forceinline__ void stage_vt(bf16_t* vt, const bf16x8 (&v)[4], int lane) {
#pragma unroll
    for (int i = 0; i < 4; ++i) { const int key = (lane >> 3) + 8 * i; *(bf16x8*)(vt + key * 80 + (lane & 7) * 8) = v[i]; }
}
typedef short s16x4 __attribute__((ext_vector_type(4)));
__device__ __forceinline__ bf16x8 read_vT(const bf16_t* vt, int dt, int lane) {
    const int fr = lane & 15, g = lane >> 4, q = fr >> 2, pq = fr & 3;
    const bf16_t* a0 = vt + (4 * g + q) * 80 + 16 * dt + 4 * pq;
    const s16x4 lo = __builtin_amdgcn_ds_read_tr16_b64_v4i16((LAS s16x4*)a0);
    const s16x4 hi = __builtin_amdgcn_ds_read_tr16_b64_v4i16((LAS s16x4*)(a0 + 16 * 80));
    return __builtin_shufflevector(lo, hi, 0, 1, 2, 3, 4, 5, 6, 7);
}

constexpr float LOG2E = 1.44269504f, LN2 = 0.69314718f;
__device__ __forceinline__ void na_wave(const Params& p, const float* rpbs  , bf16_t* vt, int seq, int r, int h, int gq, int lane) {
    const int fr = lane & 15, g = lane >> 4;
    const int c0 = gq == 0 ? 0 : (gq == 1 ? 8 : (gq == 2 ? 24 : 32));
    const int kr0 = min(max(r - 4, 0), 56);
    const int c = 16 * gq + fr, cs = min(max(c - 8, 0), 48);
    const bf16_t* zb = ws_big(p) + ((size_t)seq * SEQ + kr0 * 64 + c0) * ZLD_E + h * 64;
    const unsigned qoff = (unsigned)((r - kr0) * 64 + 16 * gq - c0 + fr) * ZLD_E + 8u * g;
    const bf16x8 q0 = *(const bf16x8*)(zb + qoff), q1 = *(const bf16x8*)(zb + qoff + 32);
    const unsigned koff = (unsigned)fr * ZLD_E + 512u + 8u * g;
    f32x4 s[16];
#pragma unroll
    for (int t = 0; t < 16; ++t) { const int kr = t >> 1, hf = t & 1;
        const bf16_t* kp = zb + (koff + (unsigned)((kr * 64 + 16 * hf) * ZLD_E));
        const bf16x8 k0 = *(const bf16x8*)kp, k1 = *(const bf16x8*)(kp + 32);
        f32x4 a = (f32x4){0.f, 0.f, 0.f, 0.f}; a = mfma16(k0, q0, a); a = mfma16(k1, q1, a); s[t] = a; }
    const unsigned voff = (unsigned)(lane >> 3) * ZLD_E + 1024u + 8u * (lane & 7);
    bf16x8 vb3[3][4];
#pragma unroll
    for (int kk2 = 0; kk2 < 2; ++kk2)
#pragma unroll
        for (int i = 0; i < 4; ++i) vb3[kk2][i] = *(const bf16x8*)(zb + (voff + (unsigned)((kk2 * 64 + 8 * i) * ZLD_E)));
    const float* rp = rpbs + (h * 15 + kr0 - r + 7) * 31 + (c0 - 16 * gq + 4 * g - fr + 15);
    const int mk = c0 + 4 * g - cs;
    float m = -1e30f;
#pragma unroll
    for (int t = 0; t < 16; ++t) { const int kr = t >> 1, hf = t & 1;
#pragma unroll
        for (int j = 0; j < 4; ++j) { const bool ok = (unsigned)(mk + 16 * hf + j) < 16u;
            float v = s[t][j] * (0.125f * LOG2E) + rp[kr * 31 + 16 * hf + j]; v = ok ? v : -1e30f; s[t][j] = v; m = fmaxf(m, v); } }
    m = fmaxf(m, __shfl_xor(m, 16)); m = fmaxf(m, __shfl_xor(m, 32));
    float l = 0.f;
#pragma unroll
    for (int t = 0; t < 16; ++t)
#pragma unroll
        for (int j = 0; j < 4; ++j) { const float e = __builtin_amdgcn_exp2f(s[t][j] - m); s[t][j] = e; l += e; }
    l += __shfl_xor(l, 16); l += __shfl_xor(l, 32);
    f32x4 o[4];
#pragma unroll
    for (int dt = 0; dt < 4; ++dt) o[dt] = (f32x4){0.f, 0.f, 0.f, 0.f};
#pragma unroll
    for (int kr = 0; kr < 8; ++kr) {
        if (kr + 2 < 8) {
#pragma unroll
            for (int i = 0; i < 4; ++i) vb3[(kr + 2) % 3][i] = *(const bf16x8*)(zb + (voff + (unsigned)(((kr + 2) * 64 + 8 * i) * ZLD_E))); }
        WAVE_SYNC();
        stage_vt(vt, vb3[kr % 3], lane);
        WAVE_SYNC();
        const bf16x8 pb = pack8(s[2 * kr], s[2 * kr + 1]);
#pragma unroll
        for (int dt = 0; dt < 4; ++dt) { const bf16x8 va = read_vT(vt, dt, lane); o[dt] = mfma16(va, pb, o[dt]); }
    }
    const float inv = __builtin_amdgcn_rcpf(l);
    bf16_t* mb = ws_mx(p) + ((size_t)seq * SEQ + r * 64 + 16 * gq) * DM + h * 64;
    const unsigned ooff = (unsigned)fr * DM + 4u * g;
#pragma unroll
    for (int dt = 0; dt < 4; ++dt) { u32x2 w; w.x = cvt_pk_bf16(o[dt][0] * inv, o[dt][1] * inv); w.y = cvt_pk_bf16(o[dt][2] * inv, o[dt][3] * inv); *(u32x2*)(mb + (ooff + 16u * dt)) = w; }
}

constexpr int HG_QLD = 136, HG_TLD = 72;
__device__ __forceinline__ void hgrn_item(const Params& p, unsigned char* lds, int lidx, int item) {
    const int tid = TID(), wid = tid >> 6, lane = tid & 63, fr = lane & 15, g = lane >> 4;
    const int seq = item >> 3, dir = (item >> 2) & 1, head = item & 3;
    bf16_t* QA = (bf16_t*)lds; bf16_t* QS = QA + 64 * HG_QLD; bf16_t* KT = QS + 64 * HG_QLD; bf16_t* KH = KT + 64 * HG_QLD; bf16_t* VT = KH + 128 * HG_TLD; bf16_t* AM = VT + 128 * HG_TLD;
    float* BC = (float*)(AM + 64 * HG_TLD); float* QT = BC + 128;
    const bf16_t* Z = ws_big(p);
    const int d = tid & 127, tq = tid >> 7, ch = head * 128 + d;
    float lb = 0.f;
    if (lidx == 1) { const float l0 = p.in[6][(0 * 2 + dir) * 512 + ch], l1 = p.in[6][(1 * 2 + dir) * 512 + ch]; lb = 1.0f / (1.0f + expf(l0 - l1)); }
    const float oml = 1.0f - lb;
    f32x4 st[8];
#pragma unroll
    for (int i = 0; i < 8; ++i) st[i] = (f32x4){0.f, 0.f, 0.f, 0.f};
    bf16_t* Od = dir == 0 ? ws_mx(p) + 512 : ws_hgb(p); const int ldo = dir == 0 ? DM : 512;
    const size_t tokb = (size_t)seq * SEQ;
    const int zcol = (dir ? 2560 : 2048) + ch;
#define LDS_BAR() do { asm volatile("s_waitcnt lgkmcnt(0)" ::: "memory"); __builtin_amdgcn_s_barrier(); asm volatile("" ::: "memory"); } while (0)
    bf16_t* RAW = (bf16_t*)(QT + 512);
#define HG_LOAD(ck_) do { const bf16_t* cb = Z + (tokb + (size_t)(dir == 0 ? (ck_) * 64 : SEQ - 64 - (ck_) * 64)) * ZLD_E;     \
        _Pragma("unroll") for (int k2 = 0; k2 < 2; ++k2) { const int id = tid + 512 * k2; const int rr = id >> 4, c8 = (id & 15) * 8; \
        const unsigned ro = (unsigned)(dir == 0 ? rr : 63 - rr) * ZLD_E + (unsigned)(head * 128 + c8); \
        rawr[0][k2] = *(const u32x4*)(cb + ro + 1536u); rawr[1][k2] = *(const u32x4*)(cb + ro + (dir ? 2560u : 2048u)); rawr[2][k2] = *(const u32x4*)(cb + ro + 3072u); } } while (0)
    u32x4 rawr[3][2];
    HG_LOAD(0);
    for (int ck = 0; ck < 64; ++ck) {
        float lf[16], qv[16], kk[16]; unsigned cv[8];
#pragma unroll
        for (int k2 = 0; k2 < 2; ++k2) { const int id = tid + 512 * k2; const int rr = id >> 4, c8 = (id & 15) * 8;
#pragma unroll
            for (int a = 0; a < 3; ++a) *(u32x4*)(RAW + (a * 64 + rr) * HG_QLD + c8) = rawr[a][k2]; }
        LDS_BAR();
        if (ck + 1 < 64) HG_LOAD(ck + 1);
#pragma unroll
        for (int e = 0; e < 16; ++e) { const int i = 16 * tq + e;
            const float q = bf2f(RAW[(0 * 64 + i) * HG_QLD + d]), z = bf2f(RAW[(1 * 64 + i) * HG_QLD + d]);
            const float ez = fexp(-z), sg = __builtin_amdgcn_rcpf(1.0f + ez); const float f = lb + oml * sg;
            lf[e] = __builtin_amdgcn_logf(f); kk[e] = oml * ez * sg; qv[e] = q * __builtin_amdgcn_rcpf(1.0f + fexp(-q)); }
#pragma unroll
        for (int e2 = 0; e2 < 8; ++e2) { const int i = 16 * tq + 2 * e2; cv[e2] = (unsigned)RAW[(2 * 64 + i) * HG_QLD + d] | ((unsigned)RAW[(2 * 64 + i + 1) * HG_QLD + d] << 16); }
#pragma unroll
        for (int e = 1; e < 16; ++e) lf[e] += lf[e - 1];
        QT[tq * 128 + d] = lf[15];
        LDS_BAR();
        const float t0 = QT[d], t1 = QT[128 + d], t2 = QT[256 + d], t3 = QT[384 + d];
        const float off = tq == 0 ? 0.f : (tq == 1 ? t0 : (tq == 2 ? t0 + t1 : t0 + t1 + t2));
        const float bref = t0 + t1, bC = t0 + t1 + t2 + t3;
        const float eref = __builtin_amdgcn_exp2f(bref), ecr = __builtin_amdgcn_exp2f(bC - bref);
        float kh[16];
#pragma unroll
        for (int e = 0; e < 16; ++e) { const int i = 16 * tq + e; const float b = lf[e] + off;
            const float e1 = __builtin_amdgcn_exp2f(fminf(fmaxf(b - bref, -115.f), 115.f)); const float r1 = __builtin_amdgcn_rcpf(e1);
            QA[i * HG_QLD + d] = f2bf(qv[e] * e1); QS[i * HG_QLD + d] = f2bf(qv[e] * e1 * eref);
            KT[i * HG_QLD + d] = f2bf(kk[e] * r1); kh[e] = kk[e] * r1 * ecr; }
        { u32x4 w0, w1; w0.x = cvt_pk_bf16(kh[0], kh[1]); w0.y = cvt_pk_bf16(kh[2], kh[3]); w0.z = cvt_pk_bf16(kh[4], kh[5]); w0.w = cvt_pk_bf16(kh[6], kh[7]);
          w1.x = cvt_pk_bf16(kh[8], kh[9]); w1.y = cvt_pk_bf16(kh[10], kh[11]); w1.z = cvt_pk_bf16(kh[12], kh[13]); w1.w = cvt_pk_bf16(kh[14], kh[15]);
          *(u32x4*)(KH + d * HG_TLD + 16 * tq) = w0; *(u32x4*)(KH + d * HG_TLD + 16 * tq + 8) = w1;
          u32x4 x0, x1; x0.x = cv[0]; x0.y = cv[1]; x0.z = cv[2]; x0.w = cv[3]; x1.x = cv[4]; x1.y = cv[5]; x1.z = cv[6]; x1.w = cv[7];
          *(u32x4*)(VT + d * HG_TLD + 16 * tq) = x0; *(u32x4*)(VT + d * HG_TLD + 16 * tq + 8) = x1; }
        if (tq == 0) BC[d] = __builtin_amdgcn_exp2f(bC);
        LDS_BAR();
        { const int ti = wid >> 1, sj0 = 2 * (wid & 1);
          f32x4 a0 = (f32x4){0.f, 0.f, 0.f, 0.f}, a1 = a0;
#pragma unroll
          for (int ks = 0; ks < 4; ++ks) { const bf16x8 qa = *(const bf16x8*)(QA + (16 * ti + fr) * HG_QLD + 32 * ks + 8 * g);
              const bf16x8 kb0 = *(const bf16x8*)(KT + (16 * sj0 + fr) * HG_QLD + 32 * ks + 8 * g), kb1 = *(const bf16x8*)(KT + (16 * sj0 + 16 + fr) * HG_QLD + 32 * ks + 8 * g);
              a0 = mfma16(qa, kb0, a0); a1 = mfma16(qa, kb1, a1); }
#pragma unroll
          for (int j = 0; j < 4; ++j) { const int t = 16 * ti + 4 * g + j, s0 = 16 * sj0 + fr, s1 = s0 + 16;
              AM[t * HG_TLD + s0] = f2bf(s0 <= t ? a0[j] : 0.f); AM[t * HG_TLD + s1] = f2bf(s1 <= t ? a1[j] : 0.f); } }
        LDS_BAR();
        bf16_t* ob = Od + (tokb + (size_t)(dir == 0 ? ck * 64 : SEQ - 64 - ck * 64)) * ldo;
        bf16x8 vb[2];
#pragma unroll
        for (int ks = 0; ks < 2; ++ks) vb[ks] = *(const bf16x8*)(VT + (16 * wid + fr) * HG_TLD + 32 * ks + 8 * g);
        bf16x8 sb[4];
#pragma unroll
        for (int pp = 0; pp < 4; ++pp) sb[pp] = pack8(st[2 * pp], st[2 * pp + 1]);
#pragma unroll
        for (int ti = 0; ti < 4; ++ti) {
            f32x4 o = (f32x4){0.f, 0.f, 0.f, 0.f};
#pragma unroll
            for (int ks = 0; ks < 2; ++ks) { const bf16x8 am = *(const bf16x8*)(AM + (16 * ti + fr) * HG_TLD + 32 * ks + 8 * g); o = mfma16(am, vb[ks], o); }
#pragma unroll
            for (int pp = 0; pp < 4; ++pp) { const bf16x4 lo = *(const bf16x4*)(QS + (16 * ti + fr) * HG_QLD + 32 * pp + 4 * g), hi = *(const bf16x4*)(QS + (16 * ti + fr) * HG_QLD + 32 * pp + 16 + 4 * g);
                const bf16x8 qs = __builtin_shufflevector(lo, hi, 0, 1, 2, 3, 4, 5, 6, 7); o = mfma16(qs, sb[pp], o); }
#pragma unroll
            for (int j = 0; j < 4; ++j) { const int i = 16 * ti + 4 * g + j;
                ob[(unsigned)(dir == 0 ? i : 63 - i) * (unsigned)ldo + (unsigned)(head * 128 + 16 * wid + fr)] = f2bf(o[j]); }
        }
#pragma unroll
        for (int i = 0; i < 8; ++i) { const f32x4 dec = *(const f32x4*)(BC + 16 * i + 4 * g); st[i] = st[i] * dec;
#pragma unroll
            for (int ks = 0; ks < 2; ++ks) { const bf16x8 khv = *(const bf16x8*)(KH + (16 * i + fr) * HG_TLD + 32 * ks + 8 * g); st[i] = mfma16(khv, vb[ks], st[i]); } }
        LDS_BAR();
    }
}
static_assert((3 * 64 * HG_QLD + 2 * 128 * HG_TLD + 64 * HG_TLD) * 2 + (128 + 512) * 4 + 3 * 64 * HG_QLD * 2 <= LDS_BYTES, "hgrn lds");

__device__ __forceinline__ void phase_even_mix(const Params& p, unsigned char* lds, int lidx) {
    const int tid = TID(), wid = __builtin_amdgcn_readfirstlane(tid >> 6), lane = tid & 63;
    for (int rep = 0; rep < ((DBG_REP & 8) ? 2 : 1); ++rep)
    for (int item = BID(); item < 160; item += GDIM()) hgrn_item(p, lds, lidx, item);
    __syncthreads();
    float* rpbs = (float*)lds + 64; bf16_t* vt = (bf16_t*)(lds + 16384) + wid * (64 * 40); int* slot = (int*)(lds + 15872);
    const float* rpb = p.in[5] + (size_t)lidx * 8 * 15 * 31;
    for (int i = tid; i < 8 * 15 * 31; i += NTHR) rpbs[i] = rpb[i] * LOG2E;
    unsigned* ctrs = (unsigned*)(p.ws + WS_CTL) + 16 + lidx * 8;
    const unsigned xcc = ((unsigned)__builtin_amdgcn_s_getreg((3 << 11) | 20)) & 7u;
    for (unsigned kq = 0; kq < 8; ++kq) { const unsigned q = (xcc + kq) & 7u;
        for (;;) {
            __syncthreads();
            if (tid == 0) *slot = (int)atomicAdd(ctrs + q, 1u);
            __syncthreads();
            const int j = __builtin_amdgcn_readfirstlane(*slot);
            if (j >= 10 * 64) break;
            const int pi = (int)q + 8 * (j >> 6), r = j & 63, seq = pi >> 2, hp = pi & 3;
            na_wave(p, rpbs, vt, seq, r, 2 * hp + (wid >> 2), wid & 3, lane);
        } }
}

__device__ __forceinline__ void phase_hgrn_fin(const Params& p, int lidx) {
    const int tid = TID(), wid = tid >> 6, lane = tid & 63;
    const bf16_t* Z = ws_big(p); bf16_t* Mx = ws_mx(p); const bf16_t* Ob = ws_hgb(p);
    const float* on = p.in[7] + lidx * 128 + (lane & 15) * 8;
    float gn[8];
#pragma unroll
    for (int e = 0; e < 8; ++e) gn[e] = on[e];
    for (int row = BID() * 8 + wid; row < NTOK; row += GDIM() * 8) {
        const bf16x8 a = *(const bf16x8*)(Mx + (size_t)row * DM + 512 + lane * 8), b = *(const bf16x8*)(Ob + (size_t)row * 512 + lane * 8), gz = *(const bf16x8*)(Z + (size_t)row * ZLD_E + 3584 + lane * 8);
        float o[8]; float ss = 0.f;
#pragma unroll
        for (int e = 0; e < 8; ++e) { o[e] = bf2f((bf16_t)a[e]) + bf2f((bf16_t)b[e]); ss += o[e] * o[e]; }
        ss += __shfl_xor(ss, 1); ss += __shfl_xor(ss, 2); ss += __shfl_xor(ss, 4); ss += __shfl_xor(ss, 8);
        const float rs = rsqrtf(ss * (1.0f / 128.0f) + 1e-6f);
        float r[8];
#pragma unroll
        for (int e = 0; e < 8; ++e) r[e] = o[e] * rs * gn[e] * siluf_(bf2f((bf16_t)gz[e]));
        u32x4 w; w.x = cvt_pk_bf16(r[0], r[1]); w.y = cvt_pk_bf16(r[2], r[3]); w.z = cvt_pk_bf16(r[4], r[5]); w.w = cvt_pk_bf16(r[6], r[7]);
        *(u32x4*)(Mx + (size_t)row * DM + 512 + lane * 8) = w;
    }
}

constexpr int RG_YLD = 72, RG_ALD = 68, RG_WAVE_LDS = 64 * RG_YLD * 2 + 2 * 16 * RG_ALD * 4;
static_assert(8 * RG_WAVE_LDS <= LDS_BYTES, "rg lds");
__device__ __forceinline__ float gelu_tanh(float x) { const float u = 0.7978845608f * (x + 0.044715f * x * x * x); const float t = 1.0f - 2.0f * __builtin_amdgcn_rcpf(1.0f + fexp(2.0f * u)); return 0.5f * x * (1.0f + t); }
template <int MODE>
__device__ __forceinline__ void rg_wave(const Params& p, unsigned char* wl, int idx, int seq, int ck, int blk, int lane) {
    const int fr = lane & 15, g = lane >> 4;
    bf16_t* ybf = (bf16_t*)wl; float* auA = (float*)(wl + 64 * RG_YLD * 2); float* auU = auA + 16 * RG_ALD;
    const bf16_t* Z = ws_big(p); bf16_t* Mx = ws_mx(p);
    float* SA = (float*)(p.ws + WS_RGS); float* SH = SA + RGS_ONE / 4; const float* HI = SH + RGS_ONE / 4;
    const size_t tokb = (size_t)seq * SEQ; const int t0 = ck * 64, ch = blk * 64 + lane;
    {
      const float* cw = p.in[10] + idx * 4 * 512; const float w0 = cw[ch], w1 = cw[512 + ch], w2 = cw[1024 + ch], w3 = cw[1536 + ch], cb = p.in[11][idx * 512 + ch];
      const bf16_t* xb = Z + tokb * ZLD_O + 512 + blk * 64;
      u32x4 xr[9];
#pragma unroll
      for (int k = 0; k < 9; ++k) { const int pc = lane + 64 * k; const int rr = pc >> 3, c8 = (pc & 7) * 8; const int t = t0 - 2 + rr;
          xr[k] = (u32x4){0u, 0u, 0u, 0u};
          if (pc < 67 * 8 && t >= 0 && t < SEQ) xr[k] = *(const u32x4*)(xb + (size_t)t * ZLD_O + c8); }
#pragma unroll
      for (int k = 0; k < 9; ++k) { const int pc = lane + 64 * k; const int rr = pc >> 3, c8 = (pc & 7) * 8; if (pc < 67 * 8) *(u32x4*)(ybf + rr * RG_YLD + c8) = xr[k]; }
      WAVE_SYNC();
      float xm2 = bf2f(ybf[0 * RG_YLD + lane]), xm1 = bf2f(ybf[1 * RG_YLD + lane]), x0 = bf2f(ybf[2 * RG_YLD + lane]);
#pragma unroll 8
      for (int t = 0; t < 64; ++t) { const float x1 = bf2f(ybf[(t + 3) * RG_YLD + lane]); const float y = w0 * xm2 + w1 * xm1 + w2 * x0 + w3 * x1 + cb;
          ybf[t * RG_YLD + lane] = f2bf(y); xm2 = xm1; xm1 = x0; x0 = x1; }
    }
    WAVE_SYNC();
    const bf16_t* rgw = (const bf16_t*)(p.ws + WS_RGW) + (size_t)idx * 131072;
    const bf16_t* zgb = Z + (tokb + t0) * ZLD_O + blk * 64; bf16_t* mxb = Mx + (tokb + t0) * DM + blk * 64;
#pragma unroll
    for (int dir = 0; dir < 2; ++dir) {
        const bf16_t* wa_ = rgw + ((dir * 2 + 0) * 8 + blk) * 4096; const bf16_t* wx_ = rgw + ((dir * 2 + 1) * 8 + blk) * 4096;
        bf16x8 wa[4][2], wx[4][2]; float ba[4], bx[4], sp8[4];
#pragma unroll
        for (int n = 0; n < 4; ++n) {
#pragma unroll
            for (int ks = 0; ks < 2; ++ks) { wa[n][ks] = *(const bf16x8*)(wa_ + (16 * n + fr) * 64 + 32 * ks + 8 * g); wx[n][ks] = *(const bf16x8*)(wx_ + (16 * n + fr) * 64 + 32 * ks + 8 * g); }
            const int chn = (idx * 2 + dir) * 512 + blk * 64 + 16 * n + fr; ba[n] = p.in[13][chn] * -1.44269504f; bx[n] = p.in[15][chn] * -1.44269504f; sp8[n] = -8.0f * 1.44269504f * log1pf(expf(-p.in[16][chn])); }
        const int sidx = ((seq * 64 + ck) * 2 + dir) * 512 + ch;
        float h = 0.f, P = 1.f; if (MODE == 1) h = HI[sidx];
        const int first = dir ? SEQ - 1 : 0;
#pragma unroll 1
        for (int tti = 0; tti < 4; ++tti) { const int tt = dir ? 3 - tti : tti;
            const bool has_first = __builtin_amdgcn_readfirstlane((int)((unsigned)(first - (t0 + 16 * tt)) < 16u)) != 0;
            bf16x8 ya[2];
#pragma unroll
            for (int ks = 0; ks < 2; ++ks) ya[ks] = *(const bf16x8*)(ybf + (16 * tt + fr) * RG_YLD + 32 * ks + 8 * g);
#define RG_ELEMS(FIRSTCHK) do { _Pragma("unroll") for (int n = 0; n < 4; ++n) { f32x4 ar = (f32x4){ba[n], ba[n], ba[n], ba[n]}, ai = (f32x4){bx[n], bx[n], bx[n], bx[n]};     \
                _Pragma("unroll") for (int ks = 0; ks < 2; ++ks) { ar = mfma16(ya[ks], wa[n][ks], ar); ai = mfma16(ya[ks], wx[n][ks], ai); } \
                _Pragma("unroll") for (int j = 0; j < 4; ++j) { const int tok = 16 * tt + 4 * g + j; const float yv = bf2f(ybf[tok * RG_YLD + 16 * n + fr]); \
                    const float r = __builtin_amdgcn_rcpf(1.0f + __builtin_amdgcn_exp2f(ar[j])), ii = __builtin_amdgcn_rcpf(1.0f + __builtin_amdgcn_exp2f(ai[j])); \
                    const float a = __builtin_amdgcn_exp2f(r * sp8[n]);       \
                    const float em = __builtin_fmaf(-a, a, 1.0f);              \
                    float sc = __builtin_amdgcn_sqrtf(em); if (FIRSTCHK) { if (t0 + tok == first) sc = 1.0f; } \
                    auA[(4 * g + j) * RG_ALD + 16 * n + fr] = a; auU[(4 * g + j) * RG_ALD + 16 * n + fr] = sc * ii * yv; } } } while (0)
            if (has_first) RG_ELEMS(true); else RG_ELEMS(false);
#undef RG_ELEMS
            WAVE_SYNC();
            bf16_t gcv[16], pv[16];
            const unsigned zo = (unsigned)(16 * tt * ZLD_O) + (unsigned)lane, mo = (unsigned)(16 * tt * DM) + (unsigned)lane;
            if (MODE == 1 && dir == 1) {
#pragma unroll
                for (int s = 0; s < 16; ++s) { gcv[s] = zgb[zo + (unsigned)(s * ZLD_O)]; pv[s] = mxb[mo + (unsigned)(s * DM)]; } }
#pragma unroll
            for (int si = 0; si < 16; ++si) { const int s = dir ? 15 - si : si; const float a = auA[s * RG_ALD + lane], u = auU[s * RG_ALD + lane]; h = a * h + u; P *= a;
                if (MODE == 1) { if (dir == 0) mxb[mo + (unsigned)(s * DM)] = f2bf(h); else mxb[mo + (unsigned)(s * DM)] = f2bf((bf2f(pv[s]) + h) * gelu_tanh(bf2f(gcv[s]))); } }
            WAVE_SYNC();
        }
        if (MODE == 0) { SA[sidx] = P; SH[sidx] = h; }
    }
}

__device__ __forceinline__ void phase_rg_carry(const Params& p) {
    float* SA = (float*)(p.ws + WS_RGS); float* SH = SA + RGS_ONE / 4; float* HI = SH + RGS_ONE / 4;
    for (int e = BID() * NTHR + TID(); e < NSEQ * 2 * 512; e += GDIM() * NTHR) { const int ch = e & 511, dir = (e >> 9) & 1, seq = e >> 10;
        float H = 0.f;
        for (int i = 0; i < 64; ++i) { const int ck = dir ? 63 - i : i; const int sidx = ((seq * 64 + ck) * 2 + dir) * 512 + ch; HI[sidx] = H; H = SA[sidx] * H + SH[sidx]; } }
}

constexpr int DL_OB = 0, DL_LSE = 3 * 256 * 64 * 2, DL_TB = DL_LSE + 3 * 256 * 4, DL_VT = DL_TB + 2048, DL_END = DL_VT + 8 * 64 * 40 * 2;
static_assert(DL_END <= LDS_BYTES, "dil lds");
struct DilTile { int br, dsh, L, res, jj0; };
__device__ __forceinline__ DilTile dil_tile(int it, int blk) { DilTile t; t.br = it >> 4; const int ti = it & 15; t.dsh = 2 * t.br; t.L = SEQ >> t.dsh;
    if (t.br == 0) { t.res = 0; t.jj0 = blk * 256 + 16 * ti; } else if (t.br == 1) { t.res = ti >> 2; t.jj0 = blk * 64 + 16 * (ti & 3); } else { t.res = ti; t.jj0 = blk * 16; }
    return t; }
__device__ __forceinline__ void dil_item(const Params& p, unsigned char* lds, int seq, int blk, int h) {
    const int tid = TID(), wid = __builtin_amdgcn_readfirstlane(tid >> 6), lane = tid & 63, fr = lane & 15, g = lane >> 4;
    bf16_t* OB = (bf16_t*)(lds + DL_OB); float* LSE = (float*)(lds + DL_LSE); float* TB = (float*)(lds + DL_TB); bf16_t* vt = (bf16_t*)(lds + DL_VT) + wid * (64 * 40);
    for (int i = tid; i < 3 * 160; i += NTHR) { const int b3 = i / 160, rel = i % 160 - 79;
        TB[i] = (rel >= -64 && rel <= 64) ? p.in[17][(int)T5_BUCKET[b3 * 129 + rel + 64] * 8 + h] * LOG2E : -1e30f; }
    __syncthreads();
    const bf16_t* Z = ws_big(p); bf16_t* Mx = ws_mx(p);
    const size_t tokb = (size_t)seq * SEQ;
    const bf16_t* zq = Z + tokb * ZLD_O + h * 64;
#define DIL_KQLOAD(T) do { const bf16_t* zr_ = zq + T.res * ZLD_O; const unsigned qo_ = (unsigned)((T.jj0 + fr) << T.dsh) * ZLD_O + 1024u + 8u * g; qf[0] = *(const bf16x8*)(zr_ + qo_); qf[1] = *(const bf16x8*)(zr_ + qo_ + 32); \
        _Pragma("unroll") for (int pq_ = 0; pq_ < 5; ++pq_) _Pragma("unroll") for (int i = 0; i < 4; ++i) { const int key = (lane >> 3) + 8 * i; const int kjj_ = min(max(T.jj0 - 64 + 32 * pq_ + key, 0), T.L - 1); \
            if (pq_ == 4 && i >= 2) kst[pq_][i] = (bf16x8){0, 0, 0, 0, 0, 0, 0, 0}; \
            else kst[pq_][i] = *(const bf16x8*)(zr_ + ((unsigned)(kjj_ << T.dsh) * ZLD_O + 1536u + 8u * (lane & 7))); } } while (0)
#define DIL_VLOAD(dst, T, pp_) do { const bf16_t* zr_ = zq + T.res * ZLD_O; _Pragma("unroll") for (int i = 0; i < 4; ++i) { const int key = (lane >> 3) + 8 * i; const int kjj_ = min(max(T.jj0 - 64 + 32 * (pp_) + key, 0), T.L - 1); \
            if ((pp_) == 4 && i >= 2) dst[i] = (bf16x8){0, 0, 0, 0, 0, 0, 0, 0};     \
            else dst[i] = *(const bf16x8*)(zr_ + ((unsigned)(kjj_ << T.dsh) * ZLD_O + 2048u + 8u * (lane & 7))); } } while (0)
    DilTile cur = dil_tile(wid, blk);
    bf16x8 qf[2], kst[5][4]; bf16x8 vb3[3][4];
    DIL_KQLOAD(cur); DIL_VLOAD(vb3[0], cur, 0); DIL_VLOAD(vb3[1], cur, 1);
#pragma unroll 1
    for (int it = wid; it < 48; it += 8) {
        const bool has_next = it + 8 < 48; const DilTile nxt = dil_tile(has_next ? it + 8 : it, blk);
        const int br = cur.br, dsh = cur.dsh, L = cur.L, res = cur.res, jj0 = cur.jj0;
        const int qtok = ((jj0 + fr) << dsh) + res;
        f32x4 s[10];
#pragma unroll
        for (int pq = 0; pq < 5; ++pq) {
            WAVE_SYNC();
            stage_vt(vt, kst[pq], lane);
            WAVE_SYNC();
#pragma unroll
            for (int tt = 0; tt < 2; ++tt) {
                if (pq == 4 && tt == 1) { s[9] = (f32x4){0.f, 0.f, 0.f, 0.f}; continue; }
                const bf16x8 k0 = *(const bf16x8*)(vt + (16 * tt + fr) * 80 + 8 * g), k1 = *(const bf16x8*)(vt + (16 * tt + fr) * 80 + 32 + 8 * g);
                f32x4 a = (f32x4){0.f, 0.f, 0.f, 0.f}; a = mfma16(k0, qf[0], a); a = mfma16(k1, qf[1], a); s[2 * pq + tt] = a; }
        }
        if (has_next) DIL_KQLOAD(nxt);
        const float* tbp = TB + br * 160 + (4 * g - fr + 15);
        float m = -1e30f;
#pragma unroll
        for (int kt = 0; kt < 9; ++kt)
#pragma unroll
            for (int j = 0; j < 4; ++j) s[kt][j] = s[kt][j] * (0.125f * LOG2E) + tbp[16 * kt + j];
        if (jj0 < 64 || jj0 + 80 > L) {
#pragma unroll
            for (int kt = 0; kt < 9; ++kt)
#pragma unroll
                for (int j = 0; j < 4; ++j) { const int kjj = jj0 - 64 + 16 * kt + 4 * g + j; s[kt][j] = (kjj >= 0 && kjj < L) ? s[kt][j] : -1e30f; } }
#pragma unroll
        for (int kt = 0; kt < 9; ++kt)
#pragma unroll
            for (int j = 0; j < 4; ++j) m = fmaxf(m, s[kt][j]);
        m = fmaxf(m, __shfl_xor(m, 16)); m = fmaxf(m, __shfl_xor(m, 32));
        float l = 0.f;
#pragma unroll
        for (int kt = 0; kt < 9; ++kt)
#pragma unroll
            for (int j = 0; j < 4; ++j) { const float e = __builtin_amdgcn_exp2f(s[kt][j] - m); s[kt][j] = e; l += e; }
        l += __shfl_xor(l, 16); l += __shfl_xor(l, 32);
        f32x4 o[4];
#pragma unroll
        for (int dt = 0; dt < 4; ++dt) o[dt] = (f32x4){0.f, 0.f, 0.f, 0.f};
#pragma unroll
        for (int pp = 0; pp < 5; ++pp) {
            if (pp + 2 < 5) DIL_VLOAD(vb3[(pp + 2) % 3], cur, pp + 2);
            WAVE_SYNC();
            stage_vt(vt, vb3[pp % 3], lane);
            WAVE_SYNC();
            if (pp == 3 && has_next) DIL_VLOAD(vb3[0], nxt, 0);
            if (pp == 4 && has_next) DIL_VLOAD(vb3[1], nxt, 1);
            const bf16x8 pb = pack8(s[2 * pp], s[2 * pp + 1]);
#pragma unroll
            for (int dt = 0; dt < 4; ++dt) { const bf16x8 va = read_vT(vt, dt, lane); o[dt] = mfma16(va, pb, o[dt]); }
        }
        const float inv = 1.0f / l; const int loc = qtok - blk * 256;
#pragma unroll
        for (int dt = 0; dt < 4; ++dt) { u32x2 w; w.x = cvt_pk_bf16(o[dt][0] * inv, o[dt][1] * inv); w.y = cvt_pk_bf16(o[dt][2] * inv, o[dt][3] * inv); *(u32x2*)(OB + (br * 256 + loc) * 64 + 16 * dt + 4 * g) = w; }
        if (g == 0) LSE[br * 256 + loc] = (m + __builtin_amdgcn_logf(l)) * LN2;
        cur = nxt;
    }
    __syncthreads();
    { const int tok = tid >> 1, hf = tid & 1; const float l0 = LSE[tok], l1 = LSE[256 + tok], l2 = LSE[512 + tok]; const float mx = fmaxf(l0, fmaxf(l1, l2));
      float w0 = __expf(l0 - mx), w1 = __expf(l1 - mx), w2 = __expf(l2 - mx); const float inv = 1.0f / (w0 + w1 + w2); w0 *= inv; w1 *= inv; w2 *= inv;
#pragma unroll
      for (int c = 0; c < 4; ++c) { const bf16x8 a0 = *(const bf16x8*)(OB + (0 * 256 + tok) * 64 + 32 * hf + 8 * c), a1 = *(const bf16x8*)(OB + (1 * 256 + tok) * 64 + 32 * hf + 8 * c), a2 = *(const bf16x8*)(OB + (2 * 256 + tok) * 64 + 32 * hf + 8 * c);
          float r[8];
#pragma unroll
          for (int e = 0; e < 8; ++e) r[e] = w0 * bf2f((bf16_t)a0[e]) + w1 * bf2f((bf16_t)a1[e]) + w2 * bf2f((bf16_t)a2[e]);
          u32x4 w; w.x = cvt_pk_bf16(r[0], r[1]); w.y = cvt_pk_bf16(r[2], r[3]); w.z = cvt_pk_bf16(r[4], r[5]); w.w = cvt_pk_bf16(r[6], r[7]);
          *(u32x4*)(Mx + (tokb + blk * 256 + tok) * DM + 512 + h * 64 + 32 * hf + 8 * c) = w; } }
    __syncthreads();
}

__device__ __forceinline__ void phase_odd_mix1(const Params& p, unsigned char* lds, int idx) {
    const int t_ = TID(); const int wid = __builtin_amdgcn_readfirstlane(t_ >> 6), lane = t_ & 63;
    if (!(DBG_SKIP & 4)) for (int it = BID(); it < NSEQ * 64; it += GDIM()) rg_wave<0>(p, lds + wid * RG_WAVE_LDS, idx, it >> 6, it & 63, wid, lane);
    __syncthreads();
    for (int rep = 0; rep < ((DBG_REP & 64) ? 2 : 1); ++rep)
    if (!(DBG_SKIP & 8)) for (int it = BID(); it < NSEQ * 16 * 8; it += GDIM()) dil_item(p, lds, it >> 7, (it >> 3) & 15, it & 7);
}
__device__ __forceinline__ void phase_odd_mix3(const Params& p, unsigned char* lds, int idx) {
    const int t_ = TID(); const int wid = __builtin_amdgcn_readfirstlane(t_ >> 6), lane = t_ & 63;
    if (!(DBG_SKIP & 4)) for (int it = BID(); it < NSEQ * 64; it += GDIM()) rg_wave<1>(p, lds + wid * RG_WAVE_LDS, idx, it >> 6, it & 63, wid, lane);
}

#define XB_TMO      128
#define XB_XCNT(j)  (256  + 64 * (j))
#define XB_XSUB(j)  (1280 + 64 * (j))
#define XB_XGEN(j)  (2304 + 64 * (j))
#define XB_TOP      3328
#define XB_TOPGEN   3392
#define XCD_BAR_WORDS 3456
#define XB_SPIN_CAP (1u << 22)
__device__ __forceinline__ unsigned xb_ld(unsigned* p)              { return __hip_atomic_load(p, __ATOMIC_RELAXED, __HIP_MEMORY_SCOPE_AGENT); }
__device__ __forceinline__ unsigned xb_add(unsigned* p, unsigned v) { return __hip_atomic_fetch_add(p, v, __ATOMIC_RELAXED, __HIP_MEMORY_SCOPE_AGENT); }
__device__ __forceinline__ unsigned xb_xcc_id() { return (unsigned)__builtin_amdgcn_s_getreg((3 << 11) | 20) & 0xFu; }
#define XB_SPIN(cond, bar) do { unsigned _sp = 0; while (cond) { __builtin_amdgcn_s_sleep(1); \
    if ((++_sp & 255u) == 0u) { if (xb_ld(&(bar)[XB_TMO])) break; if (_sp > XB_SPIN_CAP) { atomicAdd(&(bar)[XB_TMO], 1u); break; } } } } while (0)
struct XcdBarrier { unsigned* bar; unsigned x; volatile LAS unsigned* st; };
__device__ __forceinline__ XcdBarrier xcd_barrier_post(unsigned* bar, volatile LAS unsigned* st) {
    XcdBarrier b; b.bar = bar; b.x = xb_xcc_id(); b.st = st;
    if (threadIdx.x == 0) (void)xb_add(&bar[XB_XCNT(b.x)], 1u);
    return b;
}
__device__ __forceinline__ void xcd_barrier_complete(unsigned* bar, unsigned x, unsigned& nloc, unsigned& nx) {
    const unsigned G = gridDim.x * gridDim.y * gridDim.z;
    unsigned sum, cnt, mine, sp = 0u;
    for (;;) {
        sum = 0u; cnt = 0u; mine = 0u;
#pragma unroll
        for (unsigned j = 0; j < 16; ++j) { const unsigned c = xb_ld(&bar[XB_XCNT(j)]); sum += c; cnt += (c > 0u) ? 1u : 0u; mine = (j == x) ? c : mine; }
        if (sum == G) break;
        __builtin_amdgcn_s_sleep(1);
        if ((++sp & 255u) == 0u) { if (xb_ld(&bar[XB_TMO])) break; if (sp > XB_SPIN_CAP) { atomicAdd(&bar[XB_TMO], 1u); break; } }
    }
    nloc = mine > 0u ? mine : 1u; nx = cnt > 0u ? cnt : 1u;
}
__device__ __forceinline__ void xcd_barrier(const XcdBarrier& b) {
    asm volatile("s_waitcnt vmcnt(0)" ::: "memory");
    __syncthreads();
    if (threadIdx.x == 0) {
        unsigned* bar = b.bar;
        __builtin_amdgcn_s_waitcnt(0);
        unsigned nloc = b.st[0], nx = b.st[1];
        if (nloc == 0u) { xcd_barrier_complete(bar, b.x, nloc, nx); b.st[0] = nloc; b.st[1] = nx; }
        const unsigned old = xb_add(&bar[XB_XSUB(b.x)], 1u);
        const unsigned gen = old / nloc;
        if (old + 1u == (gen + 1u) * nloc) {
            __builtin_amdgcn_fence(__ATOMIC_RELEASE, "agent");
            asm volatile("s_waitcnt vmcnt(0)" ::: "memory");
            const unsigned og = xb_add(&bar[XB_TOP], 1u);
            const unsigned tg = og / nx;
            if (og + 1u == (tg + 1u) * nx) xb_add(&bar[XB_TOPGEN], 1u);
            else XB_SPIN(xb_ld(&bar[XB_TOPGEN]) == tg, bar);
            __builtin_amdgcn_fence(__ATOMIC_ACQUIRE, "agent");
            xb_add(&bar[XB_XGEN(b.x)], 1u);
            asm volatile("s_waitcnt vmcnt(0)" ::: "memory");
        } else {
            XB_SPIN(xb_ld(&bar[XB_XGEN(b.x)]) == gen, bar);
            __builtin_amdgcn_fence(__ATOMIC_ACQUIRE, "agent");
            asm volatile("s_waitcnt vmcnt(0)" ::: "memory");
        }
    }
    __syncthreads();
}

constexpr int N_PHASES = 35;
__device__ __forceinline__ void run_phase(const Params& p, unsigned char* lds, int ph) {
    if (ph == 0) { phase_prep(p, lds); return; }
    const int q = ph - 1; int layer, k;
    if (q < 8) { layer = 0; k = q; } else if (q < 17) { layer = 1; k = q - 8; } else if (q < 25) { layer = 2; k = q - 17; } else { layer = 3; k = q - 25; }
    const int idx = layer >> 1;
    if ((layer & 1) == 0) {
        if (k == 0) phase_gemm(p, lds, layer, 0);
        else if (k == 1) { if (!(DBG_SKIP & 1)) phase_even_mix(p, lds, idx); if (DBG_REP & 1) { __syncthreads(); phase_even_mix(p, lds, idx); } }
        else if (k == 2) { if (!(DBG_SKIP & 1)) phase_hgrn_fin(p, idx); }
        else if (k == 3) phase_gemm(p, lds, layer, 1);
        else if (k == 4) phase_rowpass(p, layer, 0);
        else if (k == 5) phase_gemm(p, lds, layer, 2);
        else if (k == 6) phase_gemm(p, lds, layer, 3);
        else phase_rowpass(p, layer, 1);
    } else {
        if (k == 0) phase_gemm(p, lds, layer, 0);
        else if (k == 1) { if (!(DBG_SKIP & 2)) phase_odd_mix1(p, lds, idx); if (DBG_REP & 2) { __syncthreads(); phase_odd_mix1(p, lds, idx); } }
        else if (k == 2) { if (!(DBG_SKIP & 2)) phase_rg_carry(p); }
        else if (k == 3) { if (!(DBG_SKIP & 2)) phase_odd_mix3(p, lds, idx); if (DBG_REP & 4) { __syncthreads(); phase_odd_mix3(p, lds, idx); } }
        else if (k == 4) phase_gemm(p, lds, layer, 1);
        else if (k == 5) phase_rowpass(p, layer, 0);
        else if (k == 6) phase_gemm(p, lds, layer, 2);
        else if (k == 7) phase_gemm(p, lds, layer, 3);
        else phase_rowpass(p, layer, 1);
    }
}

__global__ void __launch_bounds__(512, 2) fwd_kernel(Params p) {
    extern __shared__ __attribute__((aligned(16))) unsigned char lds[];
    cg::grid_group grid = cg::this_grid();
    volatile LAS unsigned* st = (volatile LAS unsigned*)(lds + LDS_BYTES - 16);
    if (threadIdx.x < 4) st[threadIdx.x] = 0u;
    __syncthreads();
    const XcdBarrier bar = xcd_barrier_post((unsigned*)(p.ws + WS_CTL) + 256, st);
    for (int ph = p.ph_lo; ph < p.ph_hi; ++ph) {
        if (ph == p.ph_lo + 1) grid.sync();
        else if (ph > p.ph_lo) xcd_barrier(bar);
        run_phase(p, lds, ph);
    }
}

extern "C" void kernel_launch(void* const* d_in, const int* in_sizes, int n_in, void* d_out, int out_size, void* d_ws, size_t ws_size, hipStream_t stream) {
    static int grid = 0;
    if (grid == 0) {
        if (n_in != 21 || ws_size < WS_RS + (size_t)NTOK * 4) { fprintf(stderr, "kernel_launch: unexpected n_in %d / ws_size %zu (need %zu)\n", n_in, ws_size, (size_t)WS_END); grid = -1; return; }
        int dev = 0, cus = 0, per_cu = 0;
        (void)hipGetDevice(&dev); (void)hipDeviceGetAttribute(&cus, hipDeviceAttributeMultiprocessorCount, dev);
        if (hipFuncSetAttribute((const void*)fwd_kernel, hipFuncAttributeMaxDynamicSharedMemorySize, LDS_BYTES) != hipSuccess) { fprintf(stderr, "kernel_launch: hipFuncSetAttribute failed\n"); grid = -1; return; }
        if (hipOccupancyMaxActiveBlocksPerMultiprocessor(&per_cu, (const void*)fwd_kernel, NTHR, LDS_BYTES) != hipSuccess || per_cu < 1) { fprintf(stderr, "kernel_launch: occupancy query says %d\n", per_cu); per_cu = 1; }
        (void)hipGetLastError();
        grid = cus > 0 ? cus : 256;
    }
    if (grid < 0) return;
    if (hipMemsetAsync((char*)d_ws + WS_CTL, 0, CTL_BYTES, stream) != hipSuccess) { fprintf(stderr, "kernel_launch: memset of the control words failed\n"); return; }
    Params p{};
    for (int i = 0; i < 21; ++i) p.in[i] = (const float*)d_in[i];
    p.out = (float*)d_out; p.ws = (unsigned char*)d_ws;
#if MK_MULTI_LAUNCH
    for (int ph = 0; ph < N_PHASES; ++ph) { p.ph_lo = ph; p.ph_hi = ph + 1; hipLaunchKernelGGL(fwd_kernel, dim3(grid), dim3(NTHR), LDS_BYTES, stream, p); }
#else
    p.ph_lo = 0; p.ph_hi = N_PHASES;
    void* args[] = {&p};
    hipError_t e = hipLaunchCooperativeKernel((const void*)fwd_kernel, dim3(grid), dim3(NTHR), args, LDS_BYTES, stream);
    if (e != hipSuccess) fprintf(stderr, "kernel_launch: cooperative launch failed: %s (grid %d)\n", hipGetErrorString(e), grid);
#endif
}
```

```cpp
#include <hip/hip_runtime.h>
#include <hip/hip_cooperative_groups.h>
#include <cstdio>
namespace cg = cooperative_groups;

#ifndef DBG_SKIP
#define DBG_SKIP 0
#endif
#ifndef DBG_REP
#define DBG_REP 0
#endif
#ifndef MK_MULTI_LAUNCH
#define MK_MULTI_LAUNCH 0
#endif

#define LAS __attribute__((address_space(3)))
typedef unsigned short bf16_t;
typedef short bf16x8 __attribute__((ext_vector_type(8)));
typedef short bf16x4 __attribute__((ext_vector_type(4)));
typedef float f32x4 __attribute__((ext_vector_type(4)));
typedef unsigned u32x4 __attribute__((ext_vector_type(4)));
typedef unsigned u32x2 __attribute__((ext_vector_type(2)));
typedef unsigned short us2_t __attribute__((ext_vector_type(2)));

constexpr int DM = 1024, SEQ = 4096, NSEQ = 20, NTOK = NSEQ * SEQ, MIXW = 512, DFF = 2816;
constexpr int ZLD_E = 4096, ZLD_O = 2560;
constexpr int NTHR = 512;
constexpr int LDS_BYTES = 156 * 1024;

constexpr size_t LW_WIN = 0, LW_WOUT = (size_t)4096 * 1024 * 2, LW_WGU = LW_WOUT + (size_t)1024 * 1024 * 2,
                 LW_WD = LW_WGU + (size_t)5632 * 1024 * 2, LW_STRIDE = LW_WD + (size_t)1024 * 2816 * 2;
constexpr size_t WS_CTL = 0, CTL_BYTES = 32768, WS_W = CTL_BYTES, WS_RGW = WS_W + 4 * LW_STRIDE, WS_RGS = WS_RGW + (size_t)2 * 131072 * 2;
constexpr size_t RGS_ONE = (size_t)NSEQ * 64 * 2 * 512 * 4;
constexpr size_t WS_HB = WS_RGS + 3 * RGS_ONE, WS_HGB = WS_HB + (size_t)NTOK * 1024 * 2, WS_BIG = WS_HGB + (size_t)NTOK * 512 * 2,
                 WS_END = WS_BIG + (size_t)NTOK * 4096 * 2;
constexpr size_t BIG_Y = (size_t)NTOK * DFF * 2;
constexpr size_t WS_RS = WS_END;
static_assert(WS_RS + (size_t)NTOK * 4 <= (size_t)1073741824, "workspace");
static_assert(BIG_Y + (size_t)NTOK * 1024 * 2 <= (size_t)NTOK * 4096 * 2, "Y fits");

struct Params {
    const float* in[21];
    float* out;
    unsigned char* ws;
    int ph_lo, ph_hi;
};

__device__ __forceinline__ float bf2f(bf16_t b) { return __uint_as_float(((unsigned)b) << 16); }
typedef __bf16 bf16v2_t __attribute__((ext_vector_type(2)));
typedef float f32x2 __attribute__((ext_vector_type(2)));
__device__ __forceinline__ unsigned cvt_pk_bf16(float lo, float hi) { const f32x2 v = {lo, hi}; const bf16v2_t b = __builtin_convertvector(v, bf16v2_t); return __builtin_bit_cast(unsigned, b); }
__device__ __forceinline__ bf16_t f2bf(float f) { return (bf16_t)(cvt_pk_bf16(f, 0.f) & 0xffffu); }
__device__ __forceinline__ bf16x8 pack8(f32x4 a, f32x4 b) {
    u32x4 w; w.x = cvt_pk_bf16(a[0], a[1]); w.y = cvt_pk_bf16(a[2], a[3]); w.z = cvt_pk_bf16(b[0], b[1]); w.w = cvt_pk_bf16(b[2], b[3]);
    return __builtin_bit_cast(bf16x8, w);
}
__device__ __forceinline__ f32x4 mfma16(bf16x8 a, bf16x8 b, f32x4 c) { return __builtin_amdgcn_mfma_f32_16x16x32_bf16(a, b, c, 0, 0, 0); }
#define WAVE_SYNC() asm volatile("s_waitcnt lgkmcnt(0)" ::: "memory")
__device__ __forceinline__ float fexp(float x) { return __builtin_amdgcn_exp2f(x * 1.44269504f); }
__device__ __forceinline__ float flog(float x) { return __builtin_amdgcn_logf(x) * 0.69314718f; }
__device__ __forceinline__ float sigmoidf_(float x) { return __builtin_amdgcn_rcpf(1.0f + fexp(-x)); }
__device__ __forceinline__ float siluf_(float x) { return x * sigmoidf_(x); }
__device__ __forceinline__ float wave_sum(float v) {
#pragma unroll
    for (int o = 32; o > 0; o >>= 1) v += __shfl_xor(v, o);
    return v;
}

__device__ __forceinline__ int TID() { int t = threadIdx.x; asm volatile("" : "+v"(t)); return t; }
__device__ __forceinline__ int BID() { int t = blockIdx.x; asm volatile("" : "+s"(t)); return t; }
__device__ __forceinline__ int GDIM() { int t = gridDim.x; asm volatile("" : "+s"(t)); return t; }

__constant__ unsigned char T5_BUCKET[3 * 129] = {
11,11,11,11,11,11,11,11,11,11,11,11,11,11,11,10,10,10,10,10,10,10,10,10,10,10,10,10,10,10,10,10,10,10,10,10,10,10,9,9,9,9,9,9,9,9,9,9,9,9,8,8,8,8,8,8,8,7,6,5,4,3,2,1,0,17,18,19,20,21,22,23,24,24,24,24,24,24,24,25,25,25,25,25,25,25,25,25,25,25,25,26,26,26,26,26,26,26,26,26,26,26,26,26,26,26,26,26,26,26,26,26,26,26,27,27,27,27,27,27,27,27,27,27,27,27,27,27,27,
13,13,13,13,13,13,13,13,13,13,13,13,13,13,13,13,13,13,13,13,13,13,13,12,12,12,12,12,12,12,12,12,12,12,12,12,12,12,12,12,12,12,11,11,11,11,11,11,11,11,11,11,10,10,10,10,10,10,9,9,9,8,8,4,0,20,24,24,25,25,25,26,26,26,26,26,26,27,27,27,27,27,27,27,27,27,27,28,28,28,28,28,28,28,28,28,28,28,28,28,28,28,28,28,28,28,29,29,29,29,29,29,29,29,29,29,29,29,29,29,29,29,29,29,29,29,29,29,29,
15,15,15,15,15,15,15,15,15,15,15,15,15,15,15,15,15,15,15,15,15,15,15,15,15,15,15,15,15,15,14,14,14,14,14,14,14,14,14,14,14,14,14,14,14,13,13,13,13,13,13,13,13,13,12,12,12,12,12,11,11,10,10,9,0,25,26,26,27,27,28,28,28,28,28,29,29,29,29,29,29,29,29,29,30,30,30,30,30,30,30,30,30,30,30,30,30,30,30,31,31,31,31,31,31,31,31,31,31,31,31,31,31,31,31,31,31,31,31,31,31,31,31,31,31,31,31,31,31};

namespace pg8 {
constexpr int BM = 256, BK = 64, HALF = 128, HTB = HALF * BK * 2, STAGE_BYTES = 8 * HTB, NXCD = 8, WGM = 8;
__device__ __forceinline__ int lds_byte(int r, int c) { const int st = (r >> 4) * 2 + (c >> 5), rr = r & 15, cc = c & 31, ob = rr * 64 + cc * 2; return st * 1024 + (ob ^ (((ob >> 9) & 1) << 5)); }
__device__ __forceinline__ void stage_rc(int b, int& R, int& C) { const int st = b / 1024, sb = b % 1024, swz = sb ^ (((sb >> 9) & 1) << 5); R = (st >> 1) * 16 + swz / 64; C = (st & 1) * 32 + (swz % 64) / 2; }
__device__ __forceinline__ int perm32(int rho) { const int n = rho >> 4, i = rho & 15; return 8 * (i >> 2) + 4 * n + (i & 3); }
struct Unit { int pm, pn; };
struct Gemm { const bf16_t* A; const bf16_t* Bt; int M, N, K; };
struct StaticOrder {
    int nM, nN, nwg, G, c;
    __device__ __forceinline__ void init(int M, int N, int G_, int c_) { nM = M / BM; nN = N / BM; nwg = nM * nN; G = G_; c = c_; }
    __device__ bool next(int i, Unit& u) const {
        const long L = (long)i * G + c; if (L >= nwg) return false;
        int wgid = (int)L; { const int q = nwg / NXCD, r = nwg % NXCD, xcd = wgid % NXCD, off = wgid / NXCD; wgid = (xcd < r ? xcd * (q + 1) : r * (q + 1) + (xcd - r) * q) + off; }
        const int nig = WGM * nN, gid = wgid / nig, fm = gid * WGM, gsz = (nM - fm) < WGM ? (nM - fm) : WGM;
        u.pm = fm + ((wgid % nig) % gsz); u.pn = (wgid % nig) / gsz; return true;
    }
};
struct EpiStore {
    bf16_t* O; int ldc; const float* rs;
    __device__ __forceinline__ void operator()(const f32x4 (&acc)[2][2][4][2], const Unit& u, int wr, int wc, int fr, int fq) const {
        const int row0 = u.pm * BM + wr * 64 + fr; const int col0 = u.pn * BM + wc * 32 + 8 * fq;
#pragma unroll
        for (int ai = 0; ai < 2; ++ai)
#pragma unroll
            for (int m = 0; m < 4; ++m) { const int row = row0 + ai * HALF + m * 16; bf16_t* rowp = O + (size_t)row * ldc + col0; const float sc = rs ? rs[row] : 1.0f;
#pragma unroll
                for (int bj = 0; bj < 2; ++bj) { const f32x4 v0 = acc[ai][bj][m][0] * sc, v1 = acc[ai][bj][m][1] * sc;
                    u32x4 w; w.x = cvt_pk_bf16(v0[0], v0[1]); w.y = cvt_pk_bf16(v0[2], v0[3]); w.z = cvt_pk_bf16(v1[0], v1[1]); w.w = cvt_pk_bf16(v1[2], v1[3]);
                    *(u32x4*)(rowp + bj * HALF) = w; } }
    }
};
struct EpiSwiGLU {
    bf16_t* O; int ldc; const float* rs;
    __device__ __forceinline__ void operator()(const f32x4 (&acc)[2][2][4][2], const Unit& u, int wr, int wc, int fr, int fq) const {
        const int row0 = u.pm * BM + wr * 64 + fr; const int col0 = u.pn * HALF + wc * 32 + 8 * fq;
#pragma unroll
        for (int ai = 0; ai < 2; ++ai)
#pragma unroll
            for (int m = 0; m < 4; ++m) { const int row = row0 + ai * HALF + m * 16; bf16_t* rowp = O + (size_t)row * ldc + col0; const float sc = rs[row]; const float sc2 = sc * sc, scl = sc * -1.44269504f;
                f32x4 v0, v1;
#pragma unroll
                for (int j = 0; j < 4; ++j) {
                    const float g0 = acc[ai][0][m][0][j], g1 = acc[ai][0][m][1][j];
                    v0[j] = (g0 * acc[ai][1][m][0][j]) * (sc2 * __builtin_amdgcn_rcpf(1.0f + __builtin_amdgcn_exp2f(g0 * scl)));
                    v1[j] = (g1 * acc[ai][1][m][1][j]) * (sc2 * __builtin_amdgcn_rcpf(1.0f + __builtin_amdgcn_exp2f(g1 * scl))); }
                u32x4 w; w.x = cvt_pk_bf16(v0[0], v0[1]); w.y = cvt_pk_bf16(v0[2], v0[3]); w.z = cvt_pk_bf16(v1[0], v1[1]); w.w = cvt_pk_bf16(v1[2], v1[3]);
                *(u32x4*)rowp = w; }
    }
};

template <class Epi>
__device__ __forceinline__ void gemm_phase(LAS unsigned char* lds, const Gemm g, const StaticOrder& S, const Epi& E) {
    const int tid = TID(), wid = __builtin_amdgcn_readfirstlane(tid >> 6), lane = tid & 63, wr = wid >> 2, wc = wid & 3, fr = lane & 15, fq = lane >> 4;
    const int K = g.K, nt = K / BK;
    unsigned voffA[2], voffB[2];
#pragma unroll
    for (int i = 0; i < 2; ++i) { int R, C; stage_rc(tid * 16 + i * 8192, R, C); const int Rb = (R & ~31) + perm32(R & 31);
        voffA[i] = (unsigned)(R * K + C) * 2u; voffB[i] = (unsigned)(Rb * K + C) * 2u; }
    const size_t kstep = (size_t)(BK * 2);
    const size_t hstep = (size_t)HALF * K * 2;
    const size_t tstep = 2 * hstep;
    const unsigned ldsw = (unsigned)wid * 1024u;
    const int aoff = lds_byte(wr * 64 + fr, fq * 8), boff = lds_byte(wc * 32 + fr, fq * 8);
#define PG8_SA(b, h) (((b) * 2 + (h)) * HTB)
#define PG8_SB(b, h) ((4 + (b) * 2 + (h)) * HTB)
#define PG8_STAGE(bufoff, gbase, voff) do { _Pragma("unroll") for (int _i = 0; _i < 2; ++_i) \
        __builtin_amdgcn_global_load_lds((const unsigned*)((const char*)(gbase) + (voff)[_i]), (LAS unsigned*)(lds + (bufoff) + ldsw + _i * 8192), 16, 0, 0); } while (0)
#define PG8_LDA(dst, b, h) do { _Pragma("unroll") for (int m = 0; m < 4; ++m) _Pragma("unroll") for (int k = 0; k < 2; ++k) dst[m][k] = *(const LAS bf16x8*)(lds + PG8_SA(b, h) + aoff + m * 2048 + k * 1024); } while (0)
#define PG8_LDB(dst, b, h) do { _Pragma("unroll") for (int n = 0; n < 2; ++n) _Pragma("unroll") for (int k = 0; k < 2; ++k) dst[n][k] = *(const LAS bf16x8*)(lds + PG8_SB(b, h) + boff + n * 2048 + k * 1024); } while (0)
#define PG8_MMA(ai, bj, At, Bt) do { __builtin_amdgcn_s_setprio(1); _Pragma("unroll") for (int m = 0; m < 4; ++m) _Pragma("unroll") for (int n = 0; n < 2; ++n) _Pragma("unroll") for (int k = 0; k < 2; ++k) \
        acc[ai][bj][m][n] = __builtin_amdgcn_mfma_f32_16x16x32_bf16(Bt[n][k], At[m][k], acc[ai][bj][m][n], 0, 0, 0); __builtin_amdgcn_s_setprio(0); } while (0)
#define PG8_WAIT_V(n) asm volatile("s_waitcnt vmcnt(" #n ")" ::: "memory")
#define PG8_WAIT_L(n) asm volatile("s_waitcnt lgkmcnt(" #n ")" ::: "memory")
#define PG8_BAR __builtin_amdgcn_s_barrier()
#define PG8_SCHED __builtin_amdgcn_sched_barrier(0)
    Unit cur, nxt; int ui = 0;
    if (!S.next(0, cur)) return;
    f32x4 acc[2][2][4][2];
#pragma unroll
    for (int a = 0; a < 2; ++a)
#pragma unroll
        for (int b = 0; b < 2; ++b)
#pragma unroll
            for (int m = 0; m < 4; ++m)
#pragma unroll
                for (int n = 0; n < 2; ++n) acc[a][b][m][n] = (f32x4){0.f, 0.f, 0.f, 0.f};
    bf16x8 At[4][2], B0[2][2], B1[2][2];
    const char* cA = (const char*)g.A + (size_t)cur.pm * tstep; const char* cB = (const char*)g.Bt + (size_t)cur.pn * tstep;
    PG8_STAGE(PG8_SB(0, 0), cB, voffB); PG8_STAGE(PG8_SB(0, 1), cB + hstep, voffB); PG8_STAGE(PG8_SA(0, 0), cA, voffA); PG8_STAGE(PG8_SA(0, 1), cA + hstep, voffA);
    if (wr == 1) PG8_BAR;
    PG8_WAIT_V(2); PG8_BAR;
    PG8_STAGE(PG8_SB(1, 0), cB + kstep, voffB); PG8_STAGE(PG8_SA(1, 0), cA + kstep, voffA); PG8_STAGE(PG8_SB(1, 1), cB + hstep + kstep, voffB);
    PG8_WAIT_V(6); PG8_BAR;
    for (;;) {
        const bool has_next = S.next(ui + 1, nxt);
        const char* nA = has_next ? (const char*)g.A + (size_t)nxt.pm * tstep : cA; const char* nB = has_next ? (const char*)g.Bt + (size_t)nxt.pn * tstep : cB;
        for (int t = 0; t < nt; t += 2) {
            const bool last = (t == nt - 2);
            const char* a1 = cA + (size_t)(t + 1) * kstep;
            const char* a2 = last ? nA : cA + (size_t)(t + 2) * kstep; const char* b2 = last ? nB : cB + (size_t)(t + 2) * kstep;
            const char* a3 = a2 + kstep; const char* b3 = b2 + kstep;
            PG8_LDB(B0, 0, 0); PG8_LDB(B1, 0, 1); PG8_SCHED; PG8_LDA(At, 0, 0); PG8_STAGE(PG8_SA(1, 1), a1 + hstep, voffA);
            PG8_WAIT_V(8); PG8_WAIT_L(0); PG8_BAR; PG8_MMA(0, 0, At, B0); PG8_MMA(0, 1, At, B1); PG8_BAR; PG8_SCHED;
            PG8_LDA(At, 0, 1); PG8_STAGE(PG8_SB(0, 0), b2, voffB); PG8_STAGE(PG8_SB(0, 1), b2 + hstep, voffB); PG8_STAGE(PG8_SA(0, 0), a2, voffA);
            PG8_WAIT_V(8); PG8_WAIT_L(0); PG8_BAR; PG8_MMA(1, 0, At, B0); PG8_MMA(1, 1, At, B1); PG8_BAR; PG8_SCHED;
            PG8_LDB(B0, 1, 0); PG8_LDB(B1, 1, 1); PG8_SCHED; PG8_LDA(At, 1, 0); PG8_STAGE(PG8_SA(0, 1), a2 + hstep, voffA);
            PG8_WAIT_V(8); PG8_WAIT_L(0); PG8_BAR; PG8_MMA(0, 0, At, B0); PG8_MMA(0, 1, At, B1); PG8_BAR; PG8_SCHED;
            PG8_LDA(At, 1, 1); PG8_STAGE(PG8_SB(1, 0), b3, voffB); PG8_STAGE(PG8_SB(1, 1), b3 + hstep, voffB); PG8_STAGE(PG8_SA(1, 0), a3, voffA);
            PG8_WAIT_V(8); PG8_WAIT_L(0); PG8_BAR; PG8_MMA(1, 0, At, B0); PG8_MMA(1, 1, At, B1); PG8_BAR; PG8_SCHED;
        }
        if (wr == 0) PG8_BAR;
        E(acc, cur, wr, wc, fr, fq);
        if (!has_next) break;
#pragma unroll
        for (int a = 0; a < 2; ++a)
#pragma unroll
            for (int b = 0; b < 2; ++b)
#pragma unroll
                for (int m = 0; m < 4; ++m)
#pragma unroll
                    for (int n = 0; n < 2; ++n) acc[a][b][m][n] = (f32x4){0.f, 0.f, 0.f, 0.f};
        cur = nxt; cA = nA; cB = nB; ++ui;
        if (wr == 1) PG8_BAR;
    }
    PG8_WAIT_V(0);
    PG8_BAR;
#undef PG8_SA
#undef PG8_SB
#undef PG8_STAGE
#undef PG8_LDA
#undef PG8_LDB
#undef PG8_MMA
#undef PG8_WAIT_V
#undef PG8_WAIT_L
#undef PG8_BAR
#undef PG8_SCHED
}
}

__device__ __forceinline__ bf16_t* ws_w(const Params& p, int l, size_t off) { return (bf16_t*)(p.ws + WS_W + (size_t)l * LW_STRIDE + off); }
__device__ __forceinline__ bf16_t* ws_hb(const Params& p) { return (bf16_t*)(p.ws + WS_HB); }
__device__ __forceinline__ bf16_t* ws_mx(const Params& p) { return (bf16_t*)p.out; }
__device__ __forceinline__ float* ws_rs(const Params& p) { return (float*)(p.ws + WS_RS); }
__device__ __forceinline__ bf16_t* ws_big(const Params& p) { return (bf16_t*)(p.ws + WS_BIG); }
__device__ __forceinline__ bf16_t* ws_y(const Params& p) { return (bf16_t*)(p.ws + WS_BIG + BIG_Y); }
__device__ __forceinline__ bf16_t* ws_hgb(const Params& p) { return (bf16_t*)(p.ws + WS_HGB); }
__device__ __forceinline__ const float* xin_row(const Params& p, int row) { return row < 16 * SEQ ? p.in[0] + (size_t)row * DM : p.in[1] + (size_t)(row - 16 * SEQ) * DM; }

__device__ __forceinline__ void transpose_tile(const float* W, int N, int k0, int n0, bf16_t* Wt, int ldk, int nrow0, const float* gk, float* tile  ) {
    const int tid = TID();
#pragma unroll
    for (int i = 0; i < 2; ++i) { const int r = (tid >> 4) + 32 * i, c4 = (tid & 15) * 4;
        const f32x4 v = *(const f32x4*)(W + (size_t)(k0 + r) * N + n0 + c4); const float s = gk ? gk[k0 + r] : 1.0f;
        tile[r * 65 + c4 + 0] = v[0] * s; tile[r * 65 + c4 + 1] = v[1] * s; tile[r * 65 + c4 + 2] = v[2] * s; tile[r * 65 + c4 + 3] = v[3] * s; }
    __syncthreads();
    { const int n = tid >> 3, k8 = (tid & 7) * 8; u32x4 w;
      w.x = cvt_pk_bf16(tile[(k8 + 0) * 65 + n], tile[(k8 + 1) * 65 + n]); w.y = cvt_pk_bf16(tile[(k8 + 2) * 65 + n], tile[(k8 + 3) * 65 + n]);
      w.z = cvt_pk_bf16(tile[(k8 + 4) * 65 + n], tile[(k8 + 5) * 65 + n]); w.w = cvt_pk_bf16(tile[(k8 + 6) * 65 + n], tile[(k8 + 7) * 65 + n]);
      *(u32x4*)(Wt + (size_t)(nrow0 + n) * ldk + k0 + k8) = w; }
    __syncthreads();
}

__device__ __forceinline__ void phase_prep(const Params& p, unsigned char* lds) {
    float* tile = (float*)lds;
    const int tid = TID();
    int base = 0;
    for (int l = 0; l < 4; ++l) {
        const int idx = l >> 1; const bool even = (l & 1) == 0;
        for (int m = 0; m < 5; ++m) {
            const float* src; int K = 1024, N = 1024; const float* gk = nullptr; size_t dst = 0; int mode = 0;
            if (m == 0) { N = even ? 4096 : 2560; src = even ? p.in[3] + (size_t)idx * 1024 * 4096 : p.in[8] + (size_t)idx * 1024 * 2560; gk = p.in[2] + (l * 4 + 0) * 1024; dst = LW_WIN; }
            else if (m == 1) { src = even ? p.in[4] + (size_t)idx * 1024 * 1024 : p.in[9] + (size_t)idx * 1024 * 1024; dst = LW_WOUT; }
            else if (m == 2) { N = DFF; src = p.in[18] + (size_t)l * 1024 * DFF; gk = p.in[2] + (l * 4 + 2) * 1024; dst = LW_WGU; mode = 1; }
            else if (m == 3) { N = DFF; src = p.in[19] + (size_t)l * 1024 * DFF; gk = p.in[2] + (l * 4 + 2) * 1024; dst = LW_WGU; mode = 2; }
            else { K = DFF; src = p.in[20] + (size_t)l * DFF * 1024; dst = LW_WD; }
            const int nkt = K / 64, nnt = N / 64, ntile = nkt * nnt;
            int first = BID() - (base % GDIM()); if (first < 0) first += GDIM();
            for (int t = first; t < ntile; t += GDIM()) {
                const int kt = t % nkt, ntl = t / nkt; const int n0 = ntl * 64;
                int nrow0 = n0; if (mode) nrow0 = (n0 / 128) * 256 + (n0 % 128) + (mode == 2 ? 128 : 0);
                transpose_tile(src, N, kt * 64, n0, ws_w(p, l, dst), K, nrow0, gk, tile);
            }
            base += ntile;
        }
    }
    { bf16_t* rgw = (bf16_t*)(p.ws + WS_RGW);
      for (int e = BID() * NTHR + tid; e < 2 * 2 * 2 * 8 * 4096; e += GDIM() * NTHR) {
          const int c = e & 63, d = (e >> 6) & 63, blk = (e >> 12) & 7, ax = (e >> 15) & 1, dir = (e >> 16) & 1, idx = e >> 17;
          const float* src = ax ? p.in[14] : p.in[12];
          rgw[e] = f2bf(src[(((size_t)(idx * 2 + dir) * 8 + blk) * 64 + c) * 64 + d] * -1.44269504f); } }
    { const int wid = tid >> 6, lane = tid & 63; bf16_t* hb = ws_hb(p); float* rsv = ws_rs(p);
      for (int row = BID() * 8 + wid; row < NTOK; row += GDIM() * 8) {
          const float* xr = xin_row(p, row); f32x4 v[4]; float ss = 0.f;
#pragma unroll
          for (int i = 0; i < 4; ++i) { v[i] = *(const f32x4*)(xr + i * 256 + lane * 4); ss += v[i][0] * v[i][0] + v[i][1] * v[i][1] + v[i][2] * v[i][2] + v[i][3] * v[i][3]; }
          ss = wave_sum(ss); if (lane == 0) rsv[row] = rsqrtf(ss * (1.0f / 1024.0f) + 1e-6f);
#pragma unroll
          for (int i = 0; i < 4; ++i) { u32x2 w; w.x = cvt_pk_bf16(v[i][0], v[i][1]); w.y = cvt_pk_bf16(v[i][2], v[i][3]); *(u32x2*)(hb + (size_t)row * DM + i * 256 + lane * 4) = w; } } }
}

__device__ __forceinline__ void phase_rowpass(const Params& p, int layer, int which  ) {
    const int tid = TID(), wid = tid >> 6, lane = tid & 63;
    const bf16_t* Y = ws_y(p); bf16_t* xb = ws_hb(p); float* rsv = ws_rs(p);
    const float* gp = p.in[2] + (layer * 4 + (which ? 3 : 1)) * 1024;
    const bool last = (layer == 3 && which == 1);
    float gv[2][8];
#pragma unroll
    for (int i = 0; i < 2; ++i)
#pragma unroll
        for (int e = 0; e < 8; ++e) gv[i][e] = gp[i * 512 + lane * 8 + e];
    for (int row = BID() * 8 + wid; row < NTOK; row += GDIM() * 8) {
        float xv[2][8], yv[2][8]; float ssy = 0.f;
#pragma unroll
        for (int i = 0; i < 2; ++i) { const bf16x8 xw = *(const bf16x8*)(xb + (size_t)row * DM + i * 512 + lane * 8), yw = *(const bf16x8*)(Y + (size_t)row * DM + i * 512 + lane * 8);
#pragma unroll
            for (int e = 0; e < 8; ++e) { xv[i][e] = bf2f((bf16_t)xw[e]); yv[i][e] = bf2f((bf16_t)yw[e]); ssy += yv[i][e] * yv[i][e]; } }
        ssy = wave_sum(ssy); const float rsy = rsqrtf(ssy * (1.0f / 1024.0f) + 1e-6f);
        float ssx = 0.f;
#pragma unroll
        for (int i = 0; i < 2; ++i)
#pragma unroll
            for (int e = 0; e < 8; ++e) { xv[i][e] = xv[i][e] + yv[i][e] * rsy * gv[i][e]; ssx += xv[i][e] * xv[i][e]; }
        if (last) {
#pragma unroll
            for (int i = 0; i < 2; ++i) { float* op = p.out + (size_t)row * DM + i * 512 + lane * 8;
                *(f32x4*)op = (f32x4){xv[i][0], xv[i][1], xv[i][2], xv[i][3]}; *(f32x4*)(op + 4) = (f32x4){xv[i][4], xv[i][5], xv[i][6], xv[i][7]}; }
        } else {
            ssx = wave_sum(ssx); if (lane == 0) rsv[row] = rsqrtf(ssx * (1.0f / 1024.0f) + 1e-6f);
#pragma unroll
            for (int i = 0; i < 2; ++i) { u32x4 w; w.x = cvt_pk_bf16(xv[i][0], xv[i][1]); w.y = cvt_pk_bf16(xv[i][2], xv[i][3]); w.z = cvt_pk_bf16(xv[i][4], xv[i][5]); w.w = cvt_pk_bf16(xv[i][6], xv[i][7]);
                *(u32x4*)(xb + (size_t)row * DM + i * 512 + lane * 8) = w; }
        }
    }
}

__device__ __forceinline__ void phase_gemm(const Params& p, unsigned char* lds, int layer, int which  ) {
    const bool even = (layer & 1) == 0;
    pg8::Gemm g; g.M = NTOK; pg8::StaticOrder S;
    LAS unsigned char* l3 = (LAS unsigned char*)lds;
    if (which == 2) { g.A = ws_hb(p); g.Bt = ws_w(p, layer, LW_WGU); g.N = 2 * DFF; g.K = 1024; S.init(g.M, g.N, GDIM(), BID());
        pg8::EpiSwiGLU E{ws_big(p), DFF, ws_rs(p)}; pg8::gemm_phase(l3, g, S, E); }
    else { pg8::EpiStore E;
        if (which == 0) { g.A = ws_hb(p); g.Bt = ws_w(p, layer, LW_WIN); g.N = even ? ZLD_E : ZLD_O; g.K = 1024; E.O = ws_big(p); E.ldc = g.N; E.rs = ws_rs(p); }
        else if (which == 1) { g.A = ws_mx(p); g.Bt = ws_w(p, layer, LW_WOUT); g.N = 1024; g.K = 1024; E.O = ws_y(p); E.ldc = 1024; E.rs = nullptr; }
        else { g.A = ws_big(p); g.Bt = ws_w(p, layer, LW_WD); g.N = 1024; g.K = DFF; E.O = ws_y(p); E.ldc = 1024; E.rs = nullptr; }
        S.init(g.M, g.N, GDIM(), BID()); pg8::gemm_phase(l3, g, S, E); }
}

__device__ __forceinline__ void stage_vt(bf16_t* vt, const bf16x8 (&v)[4], int lane) {
#pragma unroll
    for (int i = 0; i < 4; ++i) { const int key = (lane >> 3) + 8 * i; *(bf16x8*)(vt + key * 80 + (lane & 7) * 8) = v[i]; }
}
typedef short s16x4 __attribute__((ext_vector_type(4)));
__device__ __forceinline__ bf16x8 read_vT(const bf16_t* vt, int dt, int lane) {
    const int fr = lane & 15, g = lane >> 4, q = fr >> 2, pq = fr & 3;
    const bf16_t* a0 = vt + (4 * g + q) * 80 + 16 * dt + 4 * pq;
    const s16x4 lo = __builtin_amdgcn_ds_read_tr16_b64_v4i16((LAS s16x4*)a0);
    const s16x4 hi = __builtin_amdgcn_ds_read_tr16_b64_v4i16((LAS s16x4*)(a0 + 16 * 80));
    return __builtin_shufflevector(lo, hi, 0, 1, 2, 3, 4, 5, 6, 7);
}

constexpr float LOG2E = 1.44269504f, LN2 = 0.69314718f;
__device__ __forceinline__ void na_wave(const Params& p, const float* rpbs  , bf16_t* vt, int seq, int r, int h, int gq, int lane) {
    const int fr = lane & 15, g = lane >> 4;
    const int c0 = gq == 0 ? 0 : (gq == 1 ? 8 : (gq == 2 ? 24 : 32));
    const int kr0 = min(max(r - 4, 0), 56);
    const int c = 16 * gq + fr, cs = min(max(c - 8, 0), 48);
    const bf16_t* zb = ws_big(p) + ((size_t)seq * SEQ + kr0 * 64 + c0) * ZLD_E + h * 64;
    const unsigned qoff = (unsigned)((r - kr0) * 64 + 16 * gq - c0 + fr) * ZLD_E + 8u * g;
    const bf16x8 q0 = *(const bf16x8*)(zb + qoff), q1 = *(const bf16x8*)(zb + qoff + 32);
    const unsigned koff = (unsigned)fr * ZLD_E + 512u + 8u * g;
    f32x4 s[16];
#pragma unroll
    for (int t = 0; t < 16; ++t) { const int kr = t >> 1, hf = t & 1;
        const bf16_t* kp = zb + (koff + (unsigned)((kr * 64 + 16 * hf) * ZLD_E));
        const bf16x8 k0 = *(const bf16x8*)kp, k1 = *(const bf16x8*)(kp + 32);
        f32x4 a = (f32x4){0.f, 0.f, 0.f, 0.f}; a = mfma16(k0, q0, a); a = mfma16(k1, q1, a); s[t] = a; }
    const unsigned voff = (unsigned)(lane >> 3) * ZLD_E + 1024u + 8u * (lane & 7);
    bf16x8 vb3[3][4];
#pragma unroll
    for (int kk2 = 0; kk2 < 2; ++kk2)
#pragma unroll
        for (int i = 0; i < 4; ++i) vb3[kk2][i] = *(const bf16x8*)(zb + (voff + (unsigned)((kk2 * 64 + 8 * i) * ZLD_E)));
    const float* rp = rpbs + (h * 15 + kr0 - r + 7) * 31 + (c0 - 16 * gq + 4 * g - fr + 15);
    const int mk = c0 + 4 * g - cs;
    float m = -1e30f;
#pragma unroll
    for (int t = 0; t < 16; ++t) { const int kr = t >> 1, hf = t & 1;
#pragma unroll
        for (int j = 0; j < 4; ++j) { const bool ok = (unsigned)(mk + 16 * hf + j) < 16u;
            float v = s[t][j] * (0.125f * LOG2E) + rp[kr * 31 + 16 * hf + j]; v = ok ? v : -1e30f; s[t][j] = v; m = fmaxf(m, v); } }
    m = fmaxf(m, __shfl_xor(m, 16)); m = fmaxf(m, __shfl_xor(m, 32));
    float l = 0.f;
#pragma unroll
    for (int t = 0; t < 16; ++t)
#pragma unroll
        for (int j = 0; j < 4; ++j) { const float e = __builtin_amdgcn_exp2f(s[t][j] - m); s[t][j] = e; l += e; }
    l += __shfl_xor(l, 16); l += __shfl_xor(l, 32);
    f32x4 o[4];
#pragma unroll
    for (int dt = 0; dt < 4; ++dt) o[dt] = (f32x4){0.f, 0.f, 0.f, 0.f};
#pragma unroll
    for (int kr = 0; kr < 8; ++kr) {
        if (kr + 2 < 8) {
#pragma unroll
            for (int i = 0; i < 4; ++i) vb3[(kr + 2) % 3][i] = *(const bf16x8*)(zb + (voff + (unsigned)(((kr + 2) * 64 + 8 * i) * ZLD_E))); }
        WAVE_SYNC();
        stage_vt(vt, vb3[kr % 3], lane);
        WAVE_SYNC();
        const bf16x8 pb = pack8(s[2 * kr], s[2 * kr + 1]);
#pragma unroll
        for (int dt = 0; dt < 4; ++dt) { const bf16x8 va = read_vT(vt, dt, lane); o[dt] = mfma16(va, pb, o[dt]); }
    }
    const float inv = __builtin_amdgcn_rcpf(l);
    bf16_t* mb = ws_mx(p) + ((size_t)seq * SEQ + r * 64 + 16 * gq) * DM + h * 64;
    const unsigned ooff = (unsigned)fr * DM + 4u * g;
#pragma unroll
    for (int dt = 0; dt < 4; ++dt) { u32x2 w; w.x = cvt_pk_bf16(o[dt][0] * inv, o[dt][1] * inv); w.y = cvt_pk_bf16(o[dt][2] * inv, o[dt][3] * inv); *(u32x2*)(mb + (ooff + 16u * dt)) = w; }
}

constexpr int HG_QLD = 136, HG_TLD = 72;
__device__ __forceinline__ void hgrn_item(const Params& p, unsigned char* lds, int lidx, int item) {
    const int tid = TID(), wid = tid >> 6, lane = tid & 63, fr = lane & 15, g = lane >> 4;
    const int seq = item >> 3, dir = (item >> 2) & 1, head = item & 3;
    bf16_t* QA = (bf16_t*)lds; bf16_t* QS = QA + 64 * HG_QLD; bf16_t* KT = QS + 64 * HG_QLD; bf16_t* KH = KT + 64 * HG_QLD; bf16_t* VT = KH + 128 * HG_TLD; bf16_t* AM = VT + 128 * HG_TLD;
    float* BC = (float*)(AM + 64 * HG_TLD); float* QT = BC + 128;
    const bf16_t* Z = ws_big(p);
    const int d = tid & 127, tq = tid >> 7, ch = head * 128 + d;
    float lb = 0.f;
    if (lidx == 1) { const float l0 = p.in[6][(0 * 2 + dir) * 512 + ch], l1 = p.in[6][(1 * 2 + dir) * 512 + ch]; lb = 1.0f / (1.0f + expf(l0 - l1)); }
    const float oml = 1.0f - lb;
    f32x4 st[8];
#pragma unroll
    for (int i = 0; i < 8; ++i) st[i] = (f32x4){0.f, 0.f, 0.f, 0.f};
    bf16_t* Od = dir == 0 ? ws_mx(p) + 512 : ws_hgb(p); const int ldo = dir == 0 ? DM : 512;
    const size_t tokb = (size_t)seq * SEQ;
    const int zcol = (dir ? 2560 : 2048) + ch;
#define LDS_BAR() do { asm volatile("s_waitcnt lgkmcnt(0)" ::: "memory"); __builtin_amdgcn_s_barrier(); asm volatile("" ::: "memory"); } while (0)
    bf16_t* RAW = (bf16_t*)(QT + 512);
#define HG_LOAD(ck_) do { const bf16_t* cb = Z + (tokb + (size_t)(dir == 0 ? (ck_) * 64 : SEQ - 64 - (ck_) * 64)) * ZLD_E;     \
        _Pragma("unroll") for (int k2 = 0; k2 < 2; ++k2) { const int id = tid + 512 * k2; const int rr = id >> 4, c8 = (id & 15) * 8; \
        const unsigned ro = (unsigned)(dir == 0 ? rr : 63 - rr) * ZLD_E + (unsigned)(head * 128 + c8); \
        rawr[0][k2] = *(const u32x4*)(cb + ro + 1536u); rawr[1][k2] = *(const u32x4*)(cb + ro + (dir ? 2560u : 2048u)); rawr[2][k2] = *(const u32x4*)(cb + ro + 3072u); } } while (0)
    u32x4 rawr[3][2];
    HG_LOAD(0);
    for (int ck = 0; ck < 64; ++ck) {
        float lf[16], qv[16], kk[16]; unsigned cv[8];
#pragma unroll
        for (int k2 = 0; k2 < 2; ++k2) { const int id = tid + 512 * k2; const int rr = id >> 4, c8 = (id & 15) * 8;
#pragma unroll
            for (int a = 0; a < 3; ++a) *(u32x4*)(RAW + (a * 64 + rr) * HG_QLD + c8) = rawr[a][k2]; }
        LDS_BAR();
        if (ck + 1 < 64) HG_LOAD(ck + 1);
#pragma unroll
        for (int e = 0; e < 16; ++e) { const int i = 16 * tq + e;
            const float q = bf2f(RAW[(0 * 64 + i) * HG_QLD + d]), z = bf2f(RAW[(1 * 64 + i) * HG_QLD + d]);
            const float ez = fexp(-z), sg = __builtin_amdgcn_rcpf(1.0f + ez); const float f = lb + oml * sg;
            lf[e] = __builtin_amdgcn_logf(f); kk[e] = 1.0f - f;     qv[e] = q * __builtin_amdgcn_rcpf(1.0f + fexp(-q)); }
#pragma unroll
        for (int e2 = 0; e2 < 8; ++e2) { const int i = 16 * tq + 2 * e2; cv[e2] = (unsigned)RAW[(2 * 64 + i) * HG_QLD + d] | ((unsigned)RAW[(2 * 64 + i + 1) * HG_QLD + d] << 16); }
#pragma unroll
        for (int e = 1; e < 16; ++e) lf[e] += lf[e - 1];
        QT[tq * 128 + d] = lf[15];
        LDS_BAR();
        const float t0 = QT[d], t1 = QT[128 + d], t2 = QT[256 + d], t3 = QT[384 + d];
        const float off = tq == 0 ? 0.f : (tq == 1 ? t0 : (tq == 2 ? t0 + t1 : t0 + t1 + t2));
        const float bref = t0 + t1, bC = t0 + t1 + t2 + t3;
        const float eref = __builtin_amdgcn_exp2f(bref), ecr = __builtin_amdgcn_exp2f(bC - bref);
        float kh[16];
#pragma unroll
        for (int e = 0; e < 16; ++e) { const int i = 16 * tq + e; const float b = lf[e] + off;
            const float e1 = __builtin_amdgcn_exp2f(fminf(fmaxf(b - bref, -115.f), 115.f)); const float r1 = __builtin_amdgcn_rcpf(e1);
            QA[i * HG_QLD + d] = f2bf(qv[e] * e1); QS[i * HG_QLD + d] = f2bf(qv[e] * e1 * eref);
            KT[i * HG_QLD + d] = f2bf(kk[e] * r1); kh[e] = kk[e] * r1 * ecr; }
        { u32x4 w0, w1; w0.x = cvt_pk_bf16(kh[0], kh[1]); w0.y = cvt_pk_bf16(kh[2], kh[3]); w0.z = cvt_pk_bf16(kh[4], kh[5]); w0.w = cvt_pk_bf16(kh[6], kh[7]);
          w1.x = cvt_pk_bf16(kh[8], kh[9]); w1.y = cvt_pk_bf16(kh[10], kh[11]); w1.z = cvt_pk_bf16(kh[12], kh[13]); w1.w = cvt_pk_bf16(kh[14], kh[15]);
          *(u32x4*)(KH + d * HG_TLD + 16 * tq) = w0; *(u32x4*)(KH + d * HG_TLD + 16 * tq + 8) = w1;
          u32x4 x0, x1; x0.x = cv[0]; x0.y = cv[1]; x0.z = cv[2]; x0.w = cv[3]; x1.x = cv[4]; x1.y = cv[5]; x1.z = cv[6]; x1.w = cv[7];
          *(u32x4*)(VT + d * HG_TLD + 16 * tq) = x0; *(u32x4*)(VT + d * HG_TLD + 16 * tq + 8) = x1; }
        if (tq == 0) BC[d] = __builtin_amdgcn_exp2f(bC);
        LDS_BAR();
        { const int ti = wid >> 1, sj0 = 2 * (wid & 1);
          f32x4 a0 = (f32x4){0.f, 0.f, 0.f, 0.f}, a1 = a0;
#pragma unroll
          for (int ks = 0; ks < 4; ++ks) { const bf16x8 qa = *(const bf16x8*)(QA + (16 * ti + fr) * HG_QLD + 32 * ks + 8 * g);
              const bf16x8 kb0 = *(const bf16x8*)(KT + (16 * sj0 + fr) * HG_QLD + 32 * ks + 8 * g), kb1 = *(const bf16x8*)(KT + (16 * sj0 + 16 + fr) * HG_QLD + 32 * ks + 8 * g);
              a0 = mfma16(qa, kb0, a0); a1 = mfma16(qa, kb1, a1); }
#pragma unroll
          for (int j = 0; j < 4; ++j) { const int t = 16 * ti + 4 * g + j, s0 = 16 * sj0 + fr, s1 = s0 + 16;
              AM[t * HG_TLD + s0] = f2bf(s0 <= t ? a0[j] : 0.f); AM[t * HG_TLD + s1] = f2bf(s1 <= t ? a1[j] : 0.f); } }
        LDS_BAR();
        bf16_t* ob = Od + (tokb + (size_t)(dir == 0 ? ck * 64 : SEQ - 64 - ck * 64)) * ldo;
        bf16x8 vb[2];
#pragma unroll
        for (int ks = 0; ks < 2; ++ks) vb[ks] = *(const bf16x8*)(VT + (16 * wid + fr) * HG_TLD + 32 * ks + 8 * g);
        bf16x8 sb[4];
#pragma unroll
        for (int pp = 0; pp < 4; ++pp) sb[pp] = pack8(st[2 * pp], st[2 * pp + 1]);
#pragma unroll
        for (int ti = 0; ti < 4; ++ti) {
            f32x4 o = (f32x4){0.f, 0.f, 0.f, 0.f};
#pragma unroll
            for (int ks = 0; ks < 2; ++ks) { const bf16x8 am = *(const bf16x8*)(AM + (16 * ti + fr) * HG_TLD + 32 * ks + 8 * g); o = mfma16(am, vb[ks], o); }
#pragma unroll
            for (int pp = 0; pp < 4; ++pp) { const bf16x4 lo = *(const bf16x4*)(QS + (16 * ti + fr) * HG_QLD + 32 * pp + 4 * g), hi = *(const bf16x4*)(QS + (16 * ti + fr) * HG_QLD + 32 * pp + 16 + 4 * g);
                const bf16x8 qs = __builtin_shufflevector(lo, hi, 0, 1, 2, 3, 4, 5, 6, 7); o = mfma16(qs, sb[pp], o); }
#pragma unroll
            for (int j = 0; j < 4; ++j) { const int i = 16 * ti + 4 * g + j;
                ob[(unsigned)(dir == 0 ? i : 63 - i) * (unsigned)ldo + (unsigned)(head * 128 + 16 * wid + fr)] = f2bf(o[j]); }
        }
#pragma unroll
        for (int i = 0; i < 8; ++i) { const f32x4 dec = *(const f32x4*)(BC + 16 * i + 4 * g); st[i] = st[i] * dec;
#pragma unroll
            for (int ks = 0; ks < 2; ++ks) { const bf16x8 khv = *(const bf16x8*)(KH + (16 * i + fr) * HG_TLD + 32 * ks + 8 * g); st[i] = mfma16(khv, vb[ks], st[i]); } }
        LDS_BAR();
    }
}
static_assert((3 * 64 * HG_QLD + 2 * 128 * HG_TLD + 64 * HG_TLD) * 2 + (128 + 512) * 4 + 3 * 64 * HG_QLD * 2 <= LDS_BYTES, "hgrn lds");

__device__ __forceinline__ void phase_even_mix(const Params& p, unsigned char* lds, int lidx) {
    const int tid = TID(), wid = __builtin_amdgcn_readfirstlane(tid >> 6), lane = tid & 63;
    for (int rep = 0; rep < ((DBG_REP & 8) ? 2 : 1); ++rep)
    for (int item = BID(); item < 160; item += GDIM()) hgrn_item(p, lds, lidx, item);
    __syncthreads();
    float* rpbs = (float*)lds + 64; bf16_t* vt = (bf16_t*)(lds + 16384) + wid * (64 * 40); int* slot = (int*)(lds + 15872);
    const float* rpb = p.in[5] + (size_t)lidx * 8 * 15 * 31;
    for (int i = tid; i < 8 * 15 * 31; i += NTHR) rpbs[i] = rpb[i] * LOG2E;
    unsigned* ctrs = (unsigned*)(p.ws + WS_CTL) + 16 + lidx * 8;
    const unsigned xcc = ((unsigned)__builtin_amdgcn_s_getreg((3 << 11) | 20)) & 7u;
    for (unsigned kq = 0; kq < 8; ++kq) { const unsigned q = (xcc + kq) & 7u;
        for (;;) {
            __syncthreads();
            if (tid == 0) *slot = (int)atomicAdd(ctrs + q, 1u);
            __syncthreads();
            const int j = __builtin_amdgcn_readfirstlane(*slot);
            if (j >= 10 * 64) break;
            const int pi = (int)q + 8 * (j >> 6), r = j & 63, seq = pi >> 2, hp = pi & 3;
            na_wave(p, rpbs, vt, seq, r, 2 * hp + (wid >> 2), wid & 3, lane);
        } }
}

__device__ __forceinline__ void phase_hgrn_fin(const Params& p, int lidx) {
    const int tid = TID(), wid = tid >> 6, lane = tid & 63;
    const bf16_t* Z = ws_big(p); bf16_t* Mx = ws_mx(p); const bf16_t* Ob = ws_hgb(p);
    const float* on = p.in[7] + lidx * 128 + (lane & 15) * 8;
    float gn[8];
#pragma unroll
    for (int e = 0; e < 8; ++e) gn[e] = on[e];
    for (int row = BID() * 8 + wid; row < NTOK; row += GDIM() * 8) {
        const bf16x8 a = *(const bf16x8*)(Mx + (size_t)row * DM + 512 + lane * 8), b = *(const bf16x8*)(Ob + (size_t)row * 512 + lane * 8), gz = *(const bf16x8*)(Z + (size_t)row * ZLD_E + 3584 + lane * 8);
        float o[8]; float ss = 0.f;
#pragma unroll
        for (int e = 0; e < 8; ++e) { o[e] = bf2f((bf16_t)a[e]) + bf2f((bf16_t)b[e]); ss += o[e] * o[e]; }
        ss += __shfl_xor(ss, 1); ss += __shfl_xor(ss, 2); ss += __shfl_xor(ss, 4); ss += __shfl_xor(ss, 8);
        const float rs = rsqrtf(ss * (1.0f / 128.0f) + 1e-6f);
        float r[8];
#pragma unroll
        for (int e = 0; e < 8; ++e) r[e] = o[e] * rs * gn[e] * siluf_(bf2f((bf16_t)gz[e]));
        u32x4 w; w.x = cvt_pk_bf16(r[0], r[1]); w.y = cvt_pk_bf16(r[2], r[3]); w.z = cvt_pk_bf16(r[4], r[5]); w.w = cvt_pk_bf16(r[6], r[7]);
        *(u32x4*)(Mx + (size_t)row * DM + 512 + lane * 8) = w;
    }
}

constexpr int RG_YLD = 72, RG_ALD = 68, RG_WAVE_LDS = 64 * RG_YLD * 2 + 2 * 16 * RG_ALD * 4;
static_assert(8 * RG_WAVE_LDS <= LDS_BYTES, "rg lds");
__device__ __forceinline__ float gelu_tanh(float x) { const float w = __builtin_fmaf(x * x, -0.102943246f, -2.30220819f);
    return x * __builtin_amdgcn_rcpf(1.0f + __builtin_amdgcn_exp2f(x * w)); }
template <int MODE>
__device__ __forceinline__ void rg_wave(const Params& p, unsigned char* wl, int idx, int seq, int ck, int blk, int lane) {
    const int fr = lane & 15, g = lane >> 4;
    bf16_t* ybf = (bf16_t*)wl; float* auA = (float*)(wl + 64 * RG_YLD * 2); float* auU = auA + 16 * RG_ALD;
    const bf16_t* Z = ws_big(p); bf16_t* Mx = ws_mx(p);
    float* SA = (float*)(p.ws + WS_RGS); float* SH = SA + RGS_ONE / 4; const float* HI = SH + RGS_ONE / 4;
    const size_t tokb = (size_t)seq * SEQ; const int t0 = ck * 64, ch = blk * 64 + lane;
    {
      const float* cw = p.in[10] + idx * 4 * 512; const float w0 = cw[ch], w1 = cw[512 + ch], w2 = cw[1024 + ch], w3 = cw[1536 + ch], cb = p.in[11][idx * 512 + ch];
      const bf16_t* xb = Z + tokb * ZLD_O + 512 + blk * 64;
      u32x4 xr[9];
#pragma unroll
      for (int k = 0; k < 9; ++k) { const int pc = lane + 64 * k; const int rr = pc >> 3, c8 = (pc & 7) * 8; const int t = t0 - 2 + rr;
          xr[k] = (u32x4){0u, 0u, 0u, 0u};
          if (pc < 67 * 8 && t >= 0 && t < SEQ) xr[k] = *(const u32x4*)(xb + (size_t)t * ZLD_O + c8); }
#pragma unroll
      for (int k = 0; k < 9; ++k) { const int pc = lane + 64 * k; const int rr = pc >> 3, c8 = (pc & 7) * 8; if (pc < 67 * 8) *(u32x4*)(ybf + rr * RG_YLD + c8) = xr[k]; }
      WAVE_SYNC();
      float xm2 = bf2f(ybf[0 * RG_YLD + lane]), xm1 = bf2f(ybf[1 * RG_YLD + lane]), x0 = bf2f(ybf[2 * RG_YLD + lane]);
#pragma unroll 8
      for (int t = 0; t < 64; ++t) { const float x1 = bf2f(ybf[(t + 3) * RG_YLD + lane]); const float y = w0 * xm2 + w1 * xm1 + w2 * x0 + w3 * x1 + cb;
          ybf[t * RG_YLD + lane] = f2bf(y); xm2 = xm1; xm1 = x0; x0 = x1; }
    }
    WAVE_SYNC();
    const bf16_t* rgw = (const bf16_t*)(p.ws + WS_RGW) + (size_t)idx * 131072;
    const bf16_t* zgb = Z + (tokb + t0) * ZLD_O + blk * 64; bf16_t* mxb = Mx + (tokb + t0) * DM + blk * 64;
#pragma unroll
    for (int dir = 0; dir < 2; ++dir) {
        const bf16_t* wa_ = rgw + ((dir * 2 + 0) * 8 + blk) * 4096; const bf16_t* wx_ = rgw + ((dir * 2 + 1) * 8 + blk) * 4096;
        bf16x8 wa[4][2], wx[4][2]; float ba[4], bx[4], sp8[4];
#pragma unroll
        for (int n = 0; n < 4; ++n) {
#pragma unroll
            for (int ks = 0; ks < 2; ++ks) { wa[n][ks] = *(const bf16x8*)(wa_ + (16 * n + fr) * 64 + 32 * ks + 8 * g); wx[n][ks] = *(const bf16x8*)(wx_ + (16 * n + fr) * 64 + 32 * ks + 8 * g); }
            const int chn = (idx * 2 + dir) * 512 + blk * 64 + 16 * n + fr; ba[n] = p.in[13][chn] * -1.44269504f; bx[n] = p.in[15][chn] * -1.44269504f; sp8[n] = -8.0f * 1.44269504f * log1pf(expf(-p.in[16][chn])); }
        const int sidx = ((seq * 64 + ck) * 2 + dir) * 512 + ch;
        float h = 0.f, P = 1.f; if (MODE == 1) h = HI[sidx];
        const int first = dir ? SEQ - 1 : 0;
#pragma unroll 1
        for (int tti = 0; tti < 4; ++tti) { const int tt = dir ? 3 - tti : tti;
            const bool has_first = __builtin_amdgcn_readfirstlane((int)((unsigned)(first - (t0 + 16 * tt)) < 16u)) != 0;
            bf16x8 ya[2];
#pragma unroll
            for (int ks = 0; ks < 2; ++ks) ya[ks] = *(const bf16x8*)(ybf + (16 * tt + fr) * RG_YLD + 32 * ks + 8 * g);
#define RG_ELEMS(FIRSTCHK) do { _Pragma("unroll") for (int n = 0; n < 4; ++n) { f32x4 ar = (f32x4){ba[n], ba[n], ba[n], ba[n]}, ai = (f32x4){bx[n], bx[n], bx[n], bx[n]};     \
                _Pragma("unroll") for (int ks = 0; ks < 2; ++ks) { ar = mfma16(ya[ks], wa[n][ks], ar); ai = mfma16(ya[ks], wx[n][ks], ai); } \
                _Pragma("unroll") for (int j = 0; j < 4; ++j) { const int tok = 16 * tt + 4 * g + j; const float yv = bf2f(ybf[tok * RG_YLD + 16 * n + fr]); \
                    const float r = __builtin_amdgcn_rcpf(1.0f + __builtin_amdgcn_exp2f(ar[j])), ii = __builtin_amdgcn_rcpf(1.0f + __builtin_amdgcn_exp2f(ai[j])); \
                    const float a = __builtin_amdgcn_exp2f(r * sp8[n]);       \
                    const float em = __builtin_fmaf(-a, a, 1.0f);              \
                    float sc = __builtin_amdgcn_sqrtf(em); if (FIRSTCHK) { if (t0 + tok == first) sc = 1.0f; } \
                    auA[(4 * g + j) * RG_ALD + 16 * n + fr] = a; auU[(4 * g + j) * RG_ALD + 16 * n + fr] = sc * ii * yv; } } } while (0)
            if (has_first) RG_ELEMS(true); else RG_ELEMS(false);
#undef RG_ELEMS
            WAVE_SYNC();
            bf16_t gcv[16], pv[16];
            const unsigned zo = (unsigned)(16 * tt * ZLD_O) + (unsigned)lane, mo = (unsigned)(16 * tt * DM) + (unsigned)lane;
            if (MODE == 1 && dir == 1) {
#pragma unroll
                for (int s = 0; s < 16; ++s) { gcv[s] = zgb[zo + (unsigned)(s * ZLD_O)]; pv[s] = mxb[mo + (unsigned)(s * DM)]; } }
#pragma unroll
            for (int si = 0; si < 16; ++si) { const int s = dir ? 15 - si : si; const float a = auA[s * RG_ALD + lane], u = auU[s * RG_ALD + lane]; h = a * h + u; P *= a;
                if (MODE == 1) { if (dir == 0) mxb[mo + (unsigned)(s * DM)] = f2bf(h); else mxb[mo + (unsigned)(s * DM)] = f2bf((bf2f(pv[s]) + h) * gelu_tanh(bf2f(gcv[s]))); } }
            WAVE_SYNC();
        }
        if (MODE == 0) { SA[sidx] = P; SH[sidx] = h; }
    }
}

__device__ __forceinline__ void phase_rg_carry(const Params& p) {
    float* SA = (float*)(p.ws + WS_RGS); float* SH = SA + RGS_ONE / 4; float* HI = SH + RGS_ONE / 4;
    for (int e = BID() * NTHR + TID(); e < NSEQ * 2 * 512; e += GDIM() * NTHR) { const int ch = e & 511, dir = (e >> 9) & 1, seq = e >> 10;
        float H = 0.f;
        for (int i = 0; i < 64; ++i) { const int ck = dir ? 63 - i : i; const int sidx = ((seq * 64 + ck) * 2 + dir) * 512 + ch; HI[sidx] = H; H = SA[sidx] * H + SH[sidx]; } }
}

constexpr int DL_OB = 0, DL_LSE = 3 * 256 * 64 * 2, DL_TB = DL_LSE + 3 * 256 * 4, DL_VT = DL_TB + 2048, DL_END = DL_VT + 8 * 64 * 40 * 2;
static_assert(DL_END <= LDS_BYTES, "dil lds");
struct DilTile { int br, dsh, L, res, jj0; };
__device__ __forceinline__ DilTile dil_tile(int it, int blk) { DilTile t; t.br = it >> 4; const int ti = it & 15; t.dsh = 2 * t.br; t.L = SEQ >> t.dsh;
    if (t.br == 0) { t.res = 0; t.jj0 = blk * 256 + 16 * ti; } else if (t.br == 1) { t.res = ti >> 2; t.jj0 = blk * 64 + 16 * (ti & 3); } else { t.res = ti; t.jj0 = blk * 16; }
    return t; }
__device__ __forceinline__ void dil_item(const Params& p, unsigned char* lds, int seq, int blk, int h) {
    const int tid = TID(), wid = __builtin_amdgcn_readfirstlane(tid >> 6), lane = tid & 63, fr = lane & 15, g = lane >> 4;
    bf16_t* OB = (bf16_t*)(lds + DL_OB); float* LSE = (float*)(lds + DL_LSE); float* TB = (float*)(lds + DL_TB); bf16_t* vt = (bf16_t*)(lds + DL_VT) + wid * (64 * 40);
    for (int i = tid; i < 3 * 160; i += NTHR) { const int b3 = i / 160, rel = i % 160 - 79;
        TB[i] = (rel >= -64 && rel <= 64) ? p.in[17][(int)T5_BUCKET[b3 * 129 + rel + 64] * 8 + h] * LOG2E : -1e30f; }
    __syncthreads();
    const bf16_t* Z = ws_big(p); bf16_t* Mx = ws_mx(p);
    const size_t tokb = (size_t)seq * SEQ;
    const bf16_t* zq = Z + tokb * ZLD_O + h * 64;
#define DIL_KQLOAD(T) do { const bf16_t* zr_ = zq + T.res * ZLD_O; const unsigned qo_ = (unsigned)((T.jj0 + fr) << T.dsh) * ZLD_O + 1024u + 8u * g; qf[0] = *(const bf16x8*)(zr_ + qo_); qf[1] = *(const bf16x8*)(zr_ + qo_ + 32); \
        _Pragma("unroll") for (int pq_ = 0; pq_ < 5; ++pq_) _Pragma("unroll") for (int i = 0; i < 4; ++i) { const int key = (lane >> 3) + 8 * i; const int kjj_ = min(max(T.jj0 - 64 + 32 * pq_ + key, 0), T.L - 1); \
            if (pq_ == 4 && i >= 2) kst[pq_][i] = (bf16x8){0, 0, 0, 0, 0, 0, 0, 0}; \
            else kst[pq_][i] = *(const bf16x8*)(zr_ + ((unsigned)(kjj_ << T.dsh) * ZLD_O + 1536u + 8u * (lane & 7))); } } while (0)
#define DIL_VLOAD(dst, T, pp_) do { const bf16_t* zr_ = zq + T.res * ZLD_O; _Pragma("unroll") for (int i = 0; i < 4; ++i) { const int key = (lane >> 3) + 8 * i; const int kjj_ = min(max(T.jj0 - 64 + 32 * (pp_) + key, 0), T.L - 1); \
            if ((pp_) == 4 && i >= 2) dst[i] = (bf16x8){0, 0, 0, 0, 0, 0, 0, 0};     \
            else dst[i] = *(const bf16x8*)(zr_ + ((unsigned)(kjj_ << T.dsh) * ZLD_O + 2048u + 8u * (lane & 7))); } } while (0)
    DilTile cur = dil_tile(wid, blk);
    bf16x8 qf[2], kst[5][4]; bf16x8 vb3[3][4];
    DIL_KQLOAD(cur); DIL_VLOAD(vb3[0], cur, 0); DIL_VLOAD(vb3[1], cur, 1);
#pragma unroll 1
    for (int it = wid; it < 48; it += 8) {
        const bool has_next = it + 8 < 48; const DilTile nxt = dil_tile(has_next ? it + 8 : it, blk);
        const int br = cur.br, dsh = cur.dsh, L = cur.L, res = cur.res, jj0 = cur.jj0;
        const int qtok = ((jj0 + fr) << dsh) + res;
        f32x4 s[10];
#pragma unroll
        for (int pq = 0; pq < 5; ++pq) {
            WAVE_SYNC();
            stage_vt(vt, kst[pq], lane);
            WAVE_SYNC();
#pragma unroll
            for (int tt = 0; tt < 2; ++tt) {
                if (pq == 4 && tt == 1) { s[9] = (f32x4){0.f, 0.f, 0.f, 0.f}; continue; }
                const bf16x8 k0 = *(const bf16x8*)(vt + (16 * tt + fr) * 80 + 8 * g), k1 = *(const bf16x8*)(vt + (16 * tt + fr) * 80 + 32 + 8 * g);
                f32x4 a = (f32x4){0.f, 0.f, 0.f, 0.f}; a = mfma16(k0, qf[0], a); a = mfma16(k1, qf[1], a); s[2 * pq + tt] = a; }
        }
        if (has_next) DIL_KQLOAD(nxt);
        const float* tbp = TB + br * 160 + (4 * g - fr + 15);
        float m = -1e30f;
#pragma unroll
        for (int kt = 0; kt < 9; ++kt)
#pragma unroll
            for (int j = 0; j < 4; ++j) s[kt][j] = s[kt][j] * (0.125f * LOG2E) + tbp[16 * kt + j];
        if (jj0 < 64 || jj0 + 80 > L) {
#pragma unroll
            for (int kt = 0; kt < 9; ++kt)
#pragma unroll
                for (int j = 0; j < 4; ++j) { const int kjj = jj0 - 64 + 16 * kt + 4 * g + j; s[kt][j] = (kjj >= 0 && kjj < L) ? s[kt][j] : -1e30f; } }
#pragma unroll
        for (int kt = 0; kt < 9; ++kt)
#pragma unroll
            for (int j = 0; j < 4; ++j) m = fmaxf(m, s[kt][j]);
        m = fmaxf(m, __shfl_xor(m, 16)); m = fmaxf(m, __shfl_xor(m, 32));
        float l = 0.f;
#pragma unroll
        for (int kt = 0; kt < 9; ++kt)
#pragma unroll
            for (int j = 0; j < 4; ++j) { const float e = __builtin_amdgcn_exp2f(s[kt][j] - m); s[kt][j] = e; l += e; }
        l += __shfl_xor(l, 16); l += __shfl_xor(l, 32);
        f32x4 o[4];
#pragma unroll
        for (int dt = 0; dt < 4; ++dt) o[dt] = (f32x4){0.f, 0.f, 0.f, 0.f};
#pragma unroll
        for (int pp = 0; pp < 5; ++pp) {
            if (pp + 2 < 5) DIL_VLOAD(vb3[(pp + 2) % 3], cur, pp + 2);
            WAVE_SYNC();
            stage_vt(vt, vb3[pp % 3], lane);
            WAVE_SYNC();
            if (pp == 3 && has_next) DIL_VLOAD(vb3[0], nxt, 0);
            if (pp == 4 && has_next) DIL_VLOAD(vb3[1], nxt, 1);
            const bf16x8 pb = pack8(s[2 * pp], s[2 * pp + 1]);
#pragma unroll
            for (int dt = 0; dt < 4; ++dt) { const bf16x8 va = read_vT(vt, dt, lane); o[dt] = mfma16(va, pb, o[dt]); }
        }
        const float inv = 1.0f / l; const int loc = qtok - blk * 256;
#pragma unroll
        for (int dt = 0; dt < 4; ++dt) { u32x2 w; w.x = cvt_pk_bf16(o[dt][0] * inv, o[dt][1] * inv); w.y = cvt_pk_bf16(o[dt][2] * inv, o[dt][3] * inv); *(u32x2*)(OB + (br * 256 + loc) * 64 + 16 * dt + 4 * g) = w; }
        if (g == 0) LSE[br * 256 + loc] = (m + __builtin_amdgcn_logf(l)) * LN2;
        cur = nxt;
    }
    __syncthreads();
    { const int tok = tid >> 1, hf = tid & 1; const float l0 = LSE[tok], l1 = LSE[256 + tok], l2 = LSE[512 + tok]; const float mx = fmaxf(l0, fmaxf(l1, l2));
      float w0 = __expf(l0 - mx), w1 = __expf(l1 - mx), w2 = __expf(l2 - mx); const float inv = 1.0f / (w0 + w1 + w2); w0 *= inv; w1 *= inv; w2 *= inv;
#pragma unroll
      for (int c = 0; c < 4; ++c) { const bf16x8 a0 = *(const bf16x8*)(OB + (0 * 256 + tok) * 64 + 32 * hf + 8 * c), a1 = *(const bf16x8*)(OB + (1 * 256 + tok) * 64 + 32 * hf + 8 * c), a2 = *(const bf16x8*)(OB + (2 * 256 + tok) * 64 + 32 * hf + 8 * c);
          float r[8];
#pragma unroll
          for (int e = 0; e < 8; ++e) r[e] = w0 * bf2f((bf16_t)a0[e]) + w1 * bf2f((bf16_t)a1[e]) + w2 * bf2f((bf16_t)a2[e]);
          u32x4 w; w.x = cvt_pk_bf16(r[0], r[1]); w.y = cvt_pk_bf16(r[2], r[3]); w.z = cvt_pk_bf16(r[4], r[5]); w.w = cvt_pk_bf16(r[6], r[7]);
          *(u32x4*)(Mx + (tokb + blk * 256 + tok) * DM + 512 + h * 64 + 32 * hf + 8 * c) = w; } }
    __syncthreads();
}

__device__ __forceinline__ void phase_odd_mix1(const Params& p, unsigned char* lds, int idx) {
    const int t_ = TID(); const int wid = __builtin_amdgcn_readfirstlane(t_ >> 6), lane = t_ & 63;
    if (!(DBG_SKIP & 4)) for (int it = BID(); it < NSEQ * 64; it += GDIM()) rg_wave<0>(p, lds + wid * RG_WAVE_LDS, idx, it >> 6, it & 63, wid, lane);
    __syncthreads();
    for (int rep = 0; rep < ((DBG_REP & 64) ? 2 : 1); ++rep)
    if (!(DBG_SKIP & 8)) for (int it = BID(); it < NSEQ * 16 * 8; it += GDIM()) dil_item(p, lds, it >> 7, (it >> 3) & 15, it & 7);
}
__device__ __forceinline__ void phase_odd_mix3(const Params& p, unsigned char* lds, int idx) {
    const int t_ = TID(); const int wid = __builtin_amdgcn_readfirstlane(t_ >> 6), lane = t_ & 63;
    if (!(DBG_SKIP & 4)) for (int it = BID(); it < NSEQ * 64; it += GDIM()) rg_wave<1>(p, lds + wid * RG_WAVE_LDS, idx, it >> 6, it & 63, wid, lane);
}

#define XB_TMO      128
#define XB_XCNT(j)  (256  + 64 * (j))
#define XB_XSUB(j)  (1280 + 64 * (j))
#define XB_XGEN(j)  (2304 + 64 * (j))
#define XB_TOP      3328
#define XB_TOPGEN   3392
#define XCD_BAR_WORDS 3456
#define XB_SPIN_CAP (1u << 22)
__device__ __forceinline__ unsigned xb_ld(unsigned* p)              { return __hip_atomic_load(p, __ATOMIC_RELAXED, __HIP_MEMORY_SCOPE_AGENT); }
__device__ __forceinline__ unsigned xb_add(unsigned* p, unsigned v) { return __hip_atomic_fetch_add(p, v, __ATOMIC_RELAXED, __HIP_MEMORY_SCOPE_AGENT); }
__device__ __forceinline__ unsigned xb_xcc_id() { return (unsigned)__builtin_amdgcn_s_getreg((3 << 11) | 20) & 0xFu; }
#define XB_SPIN(cond, bar) do { unsigned _sp = 0; while (cond) { __builtin_amdgcn_s_sleep(1); \
    if ((++_sp & 255u) == 0u) { if (xb_ld(&(bar)[XB_TMO])) break; if (_sp > XB_SPIN_CAP) { atomicAdd(&(bar)[XB_TMO], 1u); break; } } } } while (0)
struct XcdBarrier { unsigned* bar; unsigned x; volatile LAS unsigned* st; };
__device__ __forceinline__ XcdBarrier xcd_barrier_post(unsigned* bar, volatile LAS unsigned* st) {
    XcdBarrier b; b.bar = bar; b.x = xb_xcc_id(); b.st = st;
    if (threadIdx.x == 0) (void)xb_add(&bar[XB_XCNT(b.x)], 1u);
    return b;
}
__device__ __forceinline__ void xcd_barrier_complete(unsigned* bar, unsigned x, unsigned& nloc, unsigned& nx) {
    const unsigned G = gridDim.x * gridDim.y * gridDim.z;
    unsigned sum, cnt, mine, sp = 0u;
    for (;;) {
        sum = 0u; cnt = 0u; mine = 0u;
#pragma unroll
        for (unsigned j = 0; j < 16; ++j) { const unsigned c = xb_ld(&bar[XB_XCNT(j)]); sum += c; cnt += (c > 0u) ? 1u : 0u; mine = (j == x) ? c : mine; }
        if (sum == G) break;
        __builtin_amdgcn_s_sleep(1);
        if ((++sp & 255u) == 0u) { if (xb_ld(&bar[XB_TMO])) break; if (sp > XB_SPIN_CAP) { atomicAdd(&bar[XB_TMO], 1u); break; } }
    }
    nloc = mine > 0u ? mine : 1u; nx = cnt > 0u ? cnt : 1u;
}
__device__ __forceinline__ void xcd_barrier(const XcdBarrier& b) {
    asm volatile("s_waitcnt vmcnt(0)" ::: "memory");
    __syncthreads();
    if (threadIdx.x == 0) {
        unsigned* bar = b.bar;
        __builtin_amdgcn_s_waitcnt(0);
        unsigned nloc = b.st[0], nx = b.st[1];
        if (nloc == 0u) { xcd_barrier_complete(bar, b.x, nloc, nx); b.st[0] = nloc; b.st[1] = nx; }
        const unsigned old = xb_add(&bar[XB_XSUB(b.x)], 1u);
        const unsigned gen = old / nloc;
        if (old + 1u == (gen + 1u) * nloc) {
            __builtin_amdgcn_fence(__ATOMIC_RELEASE, "agent");
            asm volatile("s_waitcnt vmcnt(0)" ::: "memory");
            const unsigned og = xb_add(&bar[XB_TOP], 1u);
            const unsigned tg = og / nx;
            if (og + 1u == (tg + 1u) * nx) xb_add(&bar[XB_TOPGEN], 1u);
            else XB_SPIN(xb_ld(&bar[XB_TOPGEN]) == tg, bar);
            __builtin_amdgcn_fence(__ATOMIC_ACQUIRE, "agent");
            xb_add(&bar[XB_XGEN(b.x)], 1u);
            asm volatile("s_waitcnt vmcnt(0)" ::: "memory");
        } else {
            XB_SPIN(xb_ld(&bar[XB_XGEN(b.x)]) == gen, bar);
            __builtin_amdgcn_fence(__ATOMIC_ACQUIRE, "agent");
            asm volatile("s_waitcnt vmcnt(0)" ::: "memory");
        }
    }
    __syncthreads();
}

constexpr int N_PHASES = 35;
__device__ __forceinline__ void run_phase(const Params& p, unsigned char* lds, int ph) {
    if (ph == 0) { phase_prep(p, lds); return; }
    const int q = ph - 1; int layer, k;
    if (q < 8) { layer = 0; k = q; } else if (q < 17) { layer = 1; k = q - 8; } else if (q < 25) { layer = 2; k = q - 17; } else { layer = 3; k = q - 25; }
    const int idx = layer >> 1;
    if ((layer & 1) == 0) {
        if (k == 0) phase_gemm(p, lds, layer, 0);
        else if (k == 1) { if (!(DBG_SKIP & 1)) phase_even_mix(p, lds, idx); if (DBG_REP & 1) { __syncthreads(); phase_even_mix(p, lds, idx); } }
        else if (k == 2) { if (!(DBG_SKIP & 1)) phase_hgrn_fin(p, idx); }
        else if (k == 3) phase_gemm(p, lds, layer, 1);
        else if (k == 4) phase_rowpass(p, layer, 0);
        else if (k == 5) phase_gemm(p, lds, layer, 2);
        else if (k == 6) phase_gemm(p, lds, layer, 3);
        else phase_rowpass(p, layer, 1);
    } else {
        if (k == 0) phase_gemm(p, lds, layer, 0);
        else if (k == 1) { if (!(DBG_SKIP & 2)) phase_odd_mix1(p, lds, idx); if (DBG_REP & 2) { __syncthreads(); phase_odd_mix1(p, lds, idx); } }
        else if (k == 2) { if (!(DBG_SKIP & 2)) phase_rg_carry(p); }
        else if (k == 3) { if (!(DBG_SKIP & 2)) phase_odd_mix3(p, lds, idx); if (DBG_REP & 4) { __syncthreads(); phase_odd_mix3(p, lds, idx); } }
        else if (k == 4) phase_gemm(p, lds, layer, 1);
        else if (k == 5) phase_rowpass(p, layer, 0);
        else if (k == 6) phase_gemm(p, lds, layer, 2);
        else if (k == 7) phase_gemm(p, lds, layer, 3);
        else phase_rowpass(p, layer, 1);
    }
}

__global__ void __launch_bounds__(512, 2) fwd_kernel(Params p) {
    extern __shared__ __attribute__((aligned(16))) unsigned char lds[];
    cg::grid_group grid = cg::this_grid();
    volatile LAS unsigned* st = (volatile LAS unsigned*)(lds + LDS_BYTES - 16);
    if (threadIdx.x < 4) st[threadIdx.x] = 0u;
    __syncthreads();
    const XcdBarrier bar = xcd_barrier_post((unsigned*)(p.ws + WS_CTL) + 256, st);
    for (int ph = p.ph_lo; ph < p.ph_hi; ++ph) {
        if (ph == p.ph_lo + 1) grid.sync();
        else if (ph > p.ph_lo) xcd_barrier(bar);
        run_phase(p, lds, ph);
    }
}

extern "C" void kernel_launch(void* const* d_in, const int* in_sizes, int n_in, void* d_out, int out_size, void* d_ws, size_t ws_size, hipStream_t stream) {
    static int grid = 0;
    if (grid == 0) {
        if (n_in != 21 || ws_size < WS_RS + (size_t)NTOK * 4) { fprintf(stderr, "kernel_launch: unexpected n_in %d / ws_size %zu (need %zu)\n", n_in, ws_size, (size_t)WS_END); grid = -1; return; }
        int dev = 0, cus = 0, per_cu = 0;
        (void)hipGetDevice(&dev); (void)hipDeviceGetAttribute(&cus, hipDeviceAttributeMultiprocessorCount, dev);
        if (hipFuncSetAttribute((const void*)fwd_kernel, hipFuncAttributeMaxDynamicSharedMemorySize, LDS_BYTES) != hipSuccess) { fprintf(stderr, "kernel_launch: hipFuncSetAttribute failed\n"); grid = -1; return; }
        if (hipOccupancyMaxActiveBlocksPerMultiprocessor(&per_cu, (const void*)fwd_kernel, NTHR, LDS_BYTES) != hipSuccess || per_cu < 1) { fprintf(stderr, "kernel_launch: occupancy query says %d\n", per_cu); per_cu = 1; }
        (void)hipGetLastError();
        grid = cus > 0 ? cus : 256;
    }
    if (grid < 0) return;
    if (hipMemsetAsync((char*)d_ws + WS_CTL, 0, CTL_BYTES, stream) != hipSuccess) { fprintf(stderr, "kernel_launch: memset of the control words failed\n"); return; }
    Params p{};
    for (int i = 0; i < 21; ++i) p.in[i] = (const float*)d_in[i];
    p.out = (float*)d_out; p.ws = (unsigned char*)d_ws;
#if MK_MULTI_LAUNCH
    for (int ph = 0; ph < N_PHASES; ++ph) { p.ph_lo = ph; p.ph_hi = ph + 1; hipLaunchKernelGGL(fwd_kernel, dim3(grid), dim3(NTHR), LDS_BYTES, stream, p); }
#else
    p.ph_lo = 0; p.ph_hi = N_PHASES;
    void* args[] = {&p};
    hipError_t e = hipLaunchCooperativeKernel((const void*)fwd_kernel, dim3(grid), dim3(NTHR), args, LDS_BYTES, stream);
    if (e != hipSuccess) fprintf(stderr, "kernel_launch: cooperative launch failed: %s (grid %d)\n", hipGetErrorString(e), grid);
#endif
}
```

```cpp
#include <hip/hip_runtime.h>
#include <hip/hip_cooperative_groups.h>
#include <cstdio>
namespace cg = cooperative_groups;

#ifndef DBG_SKIP
#define DBG_SKIP 0
#endif
#ifndef DBG_REP
#define DBG_REP 0
#endif
#ifndef MK_MULTI_LAUNCH
#define MK_MULTI_LAUNCH 0
#endif

#define LAS __attribute__((address_space(3)))
typedef unsigned short bf16_t;
typedef short bf16x8 __attribute__((ext_vector_type(8)));
typedef short bf16x4 __attribute__((ext_vector_type(4)));
typedef float f32x4 __attribute__((ext_vector_type(4)));
typedef unsigned u32x4 __attribute__((ext_vector_type(4)));
typedef unsigned u32x2 __attribute__((ext_vector_type(2)));
typedef unsigned short us2_t __attribute__((ext_vector_type(2)));

constexpr int DM = 1024, SEQ = 4096, NSEQ = 20, NTOK = NSEQ * SEQ, MIXW = 512, DFF = 2816;
constexpr int ZLD_E = 4096, ZLD_O = 2560;
constexpr int NTHR = 512;
constexpr int LDS_BYTES = 156 * 1024;

constexpr size_t LW_WIN = 0, LW_WOUT = (size_t)4096 * 1024 * 2, LW_WGU = LW_WOUT + (size_t)1024 * 1024 * 2,
                 LW_WD = LW_WGU + (size_t)5632 * 1024 * 2, LW_STRIDE = LW_WD + (size_t)1024 * 2816 * 2;
constexpr size_t WS_CTL = 0, CTL_BYTES = 32768, WS_W = CTL_BYTES, WS_RGW = WS_W + 4 * LW_STRIDE, WS_RGS = WS_RGW + (size_t)2 * 131072 * 2;
constexpr size_t RGS_ONE = (size_t)NSEQ * 64 * 2 * 512 * 4;
constexpr size_t WS_HB = WS_RGS + 3 * RGS_ONE, WS_HGB = WS_HB + (size_t)NTOK * 1024 * 2, WS_BIG = WS_HGB + (size_t)NTOK * 512 * 2,
                 WS_END = WS_BIG + (size_t)NTOK * 4096 * 2;
constexpr size_t BIG_Y = (size_t)NTOK * DFF * 2;
constexpr size_t WS_RS = WS_END;
static_assert(WS_RS + (size_t)NTOK * 4 <= (size_t)1073741824, "workspace");
static_assert(BIG_Y + (size_t)NTOK * 1024 * 2 <= (size_t)NTOK * 4096 * 2, "Y fits");

struct Params {
    const float* in[21];
    float* out;
    unsigned char* ws;
    int ph_lo, ph_hi;
};

__device__ __forceinline__ float bf2f(bf16_t b) { return __uint_as_float(((unsigned)b) << 16); }
typedef __bf16 bf16v2_t __attribute__((ext_vector_type(2)));
typedef float f32x2 __attribute__((ext_vector_type(2)));
__device__ __forceinline__ unsigned cvt_pk_bf16(float lo, float hi) { const f32x2 v = {lo, hi}; const bf16v2_t b = __builtin_convertvector(v, bf16v2_t); return __builtin_bit_cast(unsigned, b); }
__device__ __forceinline__ bf16_t f2bf(float f) { return (bf16_t)(cvt_pk_bf16(f, 0.f) & 0xffffu); }
__device__ __forceinline__ bf16x8 pack8(f32x4 a, f32x4 b) {
    u32x4 w; w.x = cvt_pk_bf16(a[0], a[1]); w.y = cvt_pk_bf16(a[2], a[3]); w.z = cvt_pk_bf16(b[0], b[1]); w.w = cvt_pk_bf16(b[2], b[3]);
    return __builtin_bit_cast(bf16x8, w);
}
__device__ __forceinline__ f32x4 mfma16(bf16x8 a, bf16x8 b, f32x4 c) { return __builtin_amdgcn_mfma_f32_16x16x32_bf16(a, b, c, 0, 0, 0); }
#define WAVE_SYNC() asm volatile("s_waitcnt lgkmcnt(0)" ::: "memory")
__device__ __forceinline__ float fexp(float x) { return __builtin_amdgcn_exp2f(x * 1.44269504f); }
__device__ __forceinline__ float flog(float x) { return __builtin_amdgcn_logf(x) * 0.69314718f; }
__device__ __forceinline__ float sigmoidf_(float x) { return __builtin_amdgcn_rcpf(1.0f + fexp(-x)); }
__device__ __forceinline__ float siluf_(float x) { return x * sigmoidf_(x); }
__device__ __forceinline__ float wave_sum(float v) {
#pragma unroll
    for (int o = 32; o > 0; o >>= 1) v += __shfl_xor(v, o);
    return v;
}

__device__ __forceinline__ int TID() { int t = threadIdx.x; asm volatile("" : "+v"(t)); return t; }
__device__ __forceinline__ int BID() { int t = blockIdx.x; asm volatile("" : "+s"(t)); return t; }
__device__ __forceinline__ int GDIM() { int t = gridDim.x; asm volatile("" : "+s"(t)); return t; }

__constant__ unsigned char T5_BUCKET[3 * 129] = {
11,11,11,11,11,11,11,11,11,11,11,11,11,11,11,10,10,10,10,10,10,10,10,10,10,10,10,10,10,10,10,10,10,10,10,10,10,10,9,9,9,9,9,9,9,9,9,9,9,9,8,8,8,8,8,8,8,7,6,5,4,3,2,1,0,17,18,19,20,21,22,23,24,24,24,24,24,24,24,25,25,25,25,25,25,25,25,25,25,25,25,26,26,26,26,26,26,26,26,26,26,26,26,26,26,26,26,26,26,26,26,26,26,26,27,27,27,27,27,27,27,27,27,27,27,27,27,27,27,
13,13,13,13,13,13,13,13,13,13,13,13,13,13,13,13,13,13,13,13,13,13,13,12,12,12,12,12,12,12,12,12,12,12,12,12,12,12,12,12,12,12,11,11,11,11,11,11,11,11,11,11,10,10,10,10,10,10,9,9,9,8,8,4,0,20,24,24,25,25,25,26,26,26,26,26,26,27,27,27,27,27,27,27,27,27,27,28,28,28,28,28,28,28,28,28,28,28,28,28,28,28,28,28,28,28,29,29,29,29,29,29,29,29,29,29,29,29,29,29,29,29,29,29,29,29,29,29,29,
15,15,15,15,15,15,15,15,15,15,15,15,15,15,15,15,15,15,15,15,15,15,15,15,15,15,15,15,15,15,14,14,14,14,14,14,14,14,14,14,14,14,14,14,14,13,13,13,13,13,13,13,13,13,12,12,12,12,12,11,11,10,10,9,0,25,26,26,27,27,28,28,28,28,28,29,29,29,29,29,29,29,29,29,30,30,30,30,30,30,30,30,30,30,30,30,30,30,30,31,31,31,31,31,31,31,31,31,31,31,31,31,31,31,31,31,31,31,31,31,31,31,31,31,31,31,31,31,31};

namespace pg8 {
constexpr int BM = 256, BK = 64, HALF = 128, HTB = HALF * BK * 2, STAGE_BYTES = 8 * HTB, NXCD = 8, WGM = 8;
__device__ __forceinline__ int lds_byte(int r, int c) { const int st = (r >> 4) * 2 + (c >> 5), rr = r & 15, cc = c & 31, ob = rr * 64 + cc * 2; return st * 1024 + (ob ^ (((ob >> 9) & 1) << 5)); }
__device__ __forceinline__ void stage_rc(int b, int& R, int& C) { const int st = b / 1024, sb = b % 1024, swz = sb ^ (((sb >> 9) & 1) << 5); R = (st >> 1) * 16 + swz / 64; C = (st & 1) * 32 + (swz % 64) / 2; }
__device__ __forceinline__ int perm32(int rho) { const int n = rho >> 4, i = rho & 15; return 8 * (i >> 2) + 4 * n + (i & 3); }
struct Unit { int pm, pn; };
struct Gemm { const bf16_t* A; const bf16_t* Bt; int M, N, K; };
struct StaticOrder {
    int nM, nN, nwg, G, c;
    __device__ __forceinline__ void init(int M, int N, int G_, int c_) { nM = M / BM; nN = N / BM; nwg = nM * nN; G = G_; c = c_; }
    __device__ bool next(int i, Unit& u) const {
        const long L = (long)i * G + c; if (L >= nwg) return false;
        int wgid = (int)L; { const int q = nwg / NXCD, r = nwg % NXCD, xcd = wgid % NXCD, off = wgid / NXCD; wgid = (xcd < r ? xcd * (q + 1) : r * (q + 1) + (xcd - r) * q) + off; }
        const int nig = WGM * nN, gid = wgid / nig, fm = gid * WGM, gsz = (nM - fm) < WGM ? (nM - fm) : WGM;
        u.pm = fm + ((wgid % nig) % gsz); u.pn = (wgid % nig) / gsz; return true;
    }
};
struct EpiStore {
    bf16_t* O; int ldc; const float* rs;
    __device__ __forceinline__ void operator()(const f32x4 (&acc)[2][2][4][2], const Unit& u, int wr, int wc, int fr, int fq) const {
        const int row0 = u.pm * BM + wr * 64 + fr; const int col0 = u.pn * BM + wc * 32 + 8 * fq;
#pragma unroll
        for (int ai = 0; ai < 2; ++ai)
#pragma unroll
            for (int m = 0; m < 4; ++m) { const int row = row0 + ai * HALF + m * 16; bf16_t* rowp = O + (size_t)row * ldc + col0; const float sc = rs ? rs[row] : 1.0f;
#pragma unroll
                for (int bj = 0; bj < 2; ++bj) { const f32x4 v0 = acc[ai][bj][m][0] * sc, v1 = acc[ai][bj][m][1] * sc;
                    u32x4 w; w.x = cvt_pk_bf16(v0[0], v0[1]); w.y = cvt_pk_bf16(v0[2], v0[3]); w.z = cvt_pk_bf16(v1[0], v1[1]); w.w = cvt_pk_bf16(v1[2], v1[3]);
                    *(u32x4*)(rowp + bj * HALF) = w; } }
    }
};
struct EpiSwiGLU {
    bf16_t* O; int ldc; const float* rs;
    __device__ __forceinline__ void operator()(const f32x4 (&acc)[2][2][4][2], const Unit& u, int wr, int wc, int fr, int fq) const {
        const int row0 = u.pm * BM + wr * 64 + fr; const int col0 = u.pn * HALF + wc * 32 + 8 * fq;
#pragma unroll
        for (int ai = 0; ai < 2; ++ai)
#pragma unroll
            for (int m = 0; m < 4; ++m) { const int row = row0 + ai * HALF + m * 16; bf16_t* rowp = O + (size_t)row * ldc + col0; const float sc = rs[row]; const float sc2 = sc * sc, scl = sc * -1.44269504f;
                f32x4 v0, v1;
#pragma unroll
                for (int j = 0; j < 4; ++j) {
                    const float g0 = acc[ai][0][m][0][j], g1 = acc[ai][0][m][1][j];
                    v0[j] = (g0 * acc[ai][1][m][0][j]) * (sc2 * __builtin_amdgcn_rcpf(1.0f + __builtin_amdgcn_exp2f(g0 * scl)));
                    v1[j] = (g1 * acc[ai][1][m][1][j]) * (sc2 * __builtin_amdgcn_rcpf(1.0f + __builtin_amdgcn_exp2f(g1 * scl))); }
                u32x4 w; w.x = cvt_pk_bf16(v0[0], v0[1]); w.y = cvt_pk_bf16(v0[2], v0[3]); w.z = cvt_pk_bf16(v1[0], v1[1]); w.w = cvt_pk_bf16(v1[2], v1[3]);
                *(u32x4*)rowp = w; }
    }
};

template <class Epi>
__device__ __forceinline__ void gemm_phase(LAS unsigned char* lds, const Gemm g, const StaticOrder& S, const Epi& E) {
    const int tid = TID(), wid = __builtin_amdgcn_readfirstlane(tid >> 6), lane = tid & 63, wr = wid >> 2, wc = wid & 3, fr = lane & 15, fq = lane >> 4;
    const int K = g.K, nt = K / BK;
    unsigned voffA[2], voffB[2];
#pragma unroll
    for (int i = 0; i < 2; ++i) { int R, C; stage_rc(tid * 16 + i * 8192, R, C); const int Rb = (R & ~31) + perm32(R & 31);
        voffA[i] = (unsigned)(R * K + C) * 2u; voffB[i] = (unsigned)(Rb * K + C) * 2u; }
    const size_t kstep = (size_t)(BK * 2);
    const size_t hstep = (size_t)HALF * K * 2;
    const size_t tstep = 2 * hstep;
    const unsigned ldsw = (unsigned)wid * 1024u;
    const int aoff = lds_byte(wr * 64 + fr, fq * 8), boff = lds_byte(wc * 32 + fr, fq * 8);
#define PG8_SA(b, h) (((b) * 2 + (h)) * HTB)
#define PG8_SB(b, h) ((4 + (b) * 2 + (h)) * HTB)
#define PG8_STAGE(bufoff, gbase, voff) do { _Pragma("unroll") for (int _i = 0; _i < 2; ++_i) \
        __builtin_amdgcn_global_load_lds((const unsigned*)((const char*)(gbase) + (voff)[_i]), (LAS unsigned*)(lds + (bufoff) + ldsw + _i * 8192), 16, 0, 0); } while (0)
#define PG8_LDA(dst, b, h) do { _Pragma("unroll") for (int m = 0; m < 4; ++m) _Pragma("unroll") for (int k = 0; k < 2; ++k) dst[m][k] = *(const LAS bf16x8*)(lds + PG8_SA(b, h) + aoff + m * 2048 + k * 1024); } while (0)
#define PG8_LDB(dst, b, h) do { _Pragma("unroll") for (int n = 0; n < 2; ++n) _Pragma("unroll") for (int k = 0; k < 2; ++k) dst[n][k] = *(const LAS bf16x8*)(lds + PG8_SB(b, h) + boff + n * 2048 + k * 1024); } while (0)
#define PG8_MMA(ai, bj, At, Bt) do { __builtin_amdgcn_s_setprio(1); _Pragma("unroll") for (int m = 0; m < 4; ++m) _Pragma("unroll") for (int n = 0; n < 2; ++n) _Pragma("unroll") for (int k = 0; k < 2; ++k) \
        acc[ai][bj][m][n] = __builtin_amdgcn_mfma_f32_16x16x32_bf16(Bt[n][k], At[m][k], acc[ai][bj][m][n], 0, 0, 0); __builtin_amdgcn_s_setprio(0); } while (0)
#define PG8_WAIT_V(n) asm volatile("s_waitcnt vmcnt(" #n ")" ::: "memory")
#define PG8_WAIT_L(n) asm volatile("s_waitcnt lgkmcnt(" #n ")" ::: "memory")
#define PG8_BAR __builtin_amdgcn_s_barrier()
#define PG8_SCHED __builtin_amdgcn_sched_barrier(0)
    Unit cur, nxt; int ui = 0;
    if (!S.next(0, cur)) return;
    f32x4 acc[2][2][4][2];
#pragma unroll
    for (int a = 0; a < 2; ++a)
#pragma unroll
        for (int b = 0; b < 2; ++b)
#pragma unroll
            for (int m = 0; m < 4; ++m)
#pragma unroll
                for (int n = 0; n < 2; ++n) acc[a][b][m][n] = (f32x4){0.f, 0.f, 0.f, 0.f};
    bf16x8 At[4][2], B0[2][2], B1[2][2];
    const char* cA = (const char*)g.A + (size_t)cur.pm * tstep; const char* cB = (const char*)g.Bt + (size_t)cur.pn * tstep;
    PG8_STAGE(PG8_SB(0, 0), cB, voffB); PG8_STAGE(PG8_SB(0, 1), cB + hstep, voffB); PG8_STAGE(PG8_SA(0, 0), cA, voffA); PG8_STAGE(PG8_SA(0, 1), cA + hstep, voffA);
    if (wr == 1) PG8_BAR;
    PG8_WAIT_V(2); PG8_BAR;
    PG8_STAGE(PG8_SB(1, 0), cB + kstep, voffB); PG8_STAGE(PG8_SA(1, 0), cA + kstep, voffA); PG8_STAGE(PG8_SB(1, 1), cB + hstep + kstep, voffB);
    PG8_WAIT_V(6); PG8_BAR;
    for (;;) {
        const bool has_next = S.next(ui + 1, nxt);
        const char* nA = has_next ? (const char*)g.A + (size_t)nxt.pm * tstep : cA; const char* nB = has_next ? (const char*)g.Bt + (size_t)nxt.pn * tstep : cB;
        for (int t = 0; t < nt; t += 2) {
            const bool last = (t == nt - 2);
            const char* a1 = cA + (size_t)(t + 1) * kstep;
            const char* a2 = last ? nA : cA + (size_t)(t + 2) * kstep; const char* b2 = last ? nB : cB + (size_t)(t + 2) * kstep;
            const char* a3 = a2 + kstep; const char* b3 = b2 + kstep;
            PG8_LDB(B0, 0, 0); PG8_LDB(B1, 0, 1); PG8_SCHED; PG8_LDA(At, 0, 0); PG8_STAGE(PG8_SA(1, 1), a1 + hstep, voffA);
            PG8_WAIT_V(8); PG8_WAIT_L(0); PG8_BAR; PG8_MMA(0, 0, At, B0); PG8_MMA(0, 1, At, B1); PG8_BAR; PG8_SCHED;
            PG8_LDA(At, 0, 1); PG8_STAGE(PG8_SB(0, 0), b2, voffB); PG8_STAGE(PG8_SB(0, 1), b2 + hstep, voffB); PG8_STAGE(PG8_SA(0, 0), a2, voffA);
            PG8_WAIT_V(8); PG8_WAIT_L(0); PG8_BAR; PG8_MMA(1, 0, At, B0); PG8_MMA(1, 1, At, B1); PG8_BAR; PG8_SCHED;
            PG8_LDB(B0, 1, 0); PG8_LDB(B1, 1, 1); PG8_SCHED; PG8_LDA(At, 1, 0); PG8_STAGE(PG8_SA(0, 1), a2 + hstep, voffA);
            PG8_WAIT_V(8); PG8_WAIT_L(0); PG8_BAR; PG8_MMA(0, 0, At, B0); PG8_MMA(0, 1, At, B1); PG8_BAR; PG8_SCHED;
            PG8_LDA(At, 1, 1); PG8_STAGE(PG8_SB(1, 0), b3, voffB); PG8_STAGE(PG8_SB(1, 1), b3 + hstep, voffB); PG8_STAGE(PG8_SA(1, 0), a3, voffA);
            PG8_WAIT_V(8); PG8_WAIT_L(0); PG8_BAR; PG8_MMA(1, 0, At, B0); PG8_MMA(1, 1, At, B1); PG8_BAR; PG8_SCHED;
        }
        if (wr == 0) PG8_BAR;
        E(acc, cur, wr, wc, fr, fq);
        if (!has_next) break;
#pragma unroll
        for (int a = 0; a < 2; ++a)
#pragma unroll
            for (int b = 0; b < 2; ++b)
#pragma unroll
                for (int m = 0; m < 4; ++m)
#pragma unroll
                    for (int n = 0; n < 2; ++n) acc[a][b][m][n] = (f32x4){0.f, 0.f, 0.f, 0.f};
        cur = nxt; cA = nA; cB = nB; ++ui;
        if (wr == 1) PG8_BAR;
    }
    PG8_WAIT_V(0);
    PG8_BAR;
#undef PG8_SA
#undef PG8_SB
#undef PG8_STAGE
#undef PG8_LDA
#undef PG8_LDB
#undef PG8_MMA
#undef PG8_WAIT_V
#undef PG8_WAIT_L
#undef PG8_BAR
#undef PG8_SCHED
}
}

__device__ __forceinline__ bf16_t* ws_w(const Params& p, int l, size_t off) { return (bf16_t*)(p.ws + WS_W + (size_t)l * LW_STRIDE + off); }
__device__ __forceinline__ bf16_t* ws_hb(const Params& p) { return (bf16_t*)(p.ws + WS_HB); }
__device__ __forceinline__ bf16_t* ws_mx(const Params& p) { return (bf16_t*)p.out; }
__device__ __forceinline__ float* ws_rs(const Params& p) { return (float*)(p.ws + WS_RS); }
__device__ __forceinline__ bf16_t* ws_big(const Params& p) { return (bf16_t*)(p.ws + WS_BIG); }
__device__ __forceinline__ bf16_t* ws_y(const Params& p) { return (bf16_t*)(p.ws + WS_BIG + BIG_Y); }
__device__ __forceinline__ bf16_t* ws_hgb(const Params& p) { return (bf16_t*)(p.ws + WS_HGB); }
__device__ __forceinline__ const float* xin_row(const Params& p, int row) { return row < 16 * SEQ ? p.in[0] + (size_t)row * DM : p.in[1] + (size_t)(row - 16 * SEQ) * DM; }

__device__ __forceinline__ void transpose_tile(const float* W, int N, int k0, int n0, bf16_t* Wt, int ldk, int nrow0, const float* gk, float* tile  ) {
    const int tid = TID();
#pragma unroll
    for (int i = 0; i < 2; ++i) { const int r = (tid >> 4) + 32 * i, c4 = (tid & 15) * 4;
        const f32x4 v = *(const f32x4*)(W + (size_t)(k0 + r) * N + n0 + c4); const float s = gk ? gk[k0 + r] : 1.0f;
        tile[r * 65 + c4 + 0] = v[0] * s; tile[r * 65 + c4 + 1] = v[1] * s; tile[r * 65 + c4 + 2] = v[2] * s; tile[r * 65 + c4 + 3] = v[3] * s; }
    __syncthreads();
    { const int n = tid >> 3, k8 = (tid & 7) * 8; u32x4 w;
      w.x = cvt_pk_bf16(tile[(k8 + 0) * 65 + n], tile[(k8 + 1) * 65 + n]); w.y = cvt_pk_bf16(tile[(k8 + 2) * 65 + n], tile[(k8 + 3) * 65 + n]);
      w.z = cvt_pk_bf16(tile[(k8 + 4) * 65 + n], tile[(k8 + 5) * 65 + n]); w.w = cvt_pk_bf16(tile[(k8 + 6) * 65 + n], tile[(k8 + 7) * 65 + n]);
      *(u32x4*)(Wt + (size_t)(nrow0 + n) * ldk + k0 + k8) = w; }
    __syncthreads();
}

__device__ __forceinline__ void phase_prep(const Params& p, unsigned char* lds) {
    float* tile = (float*)lds;
    const int tid = TID();
    int base = 0;
    for (int l = 0; l < 4; ++l) {
        const int idx = l >> 1; const bool even = (l & 1) == 0;
        for (int m = 0; m < 5; ++m) {
            const float* src; int K = 1024, N = 1024; const float* gk = nullptr; size_t dst = 0; int mode = 0;
            if (m == 0) { N = even ? 4096 : 2560; src = even ? p.in[3] + (size_t)idx * 1024 * 4096 : p.in[8] + (size_t)idx * 1024 * 2560; gk = p.in[2] + (l * 4 + 0) * 1024; dst = LW_WIN; }
            else if (m == 1) { src = even ? p.in[4] + (size_t)idx * 1024 * 1024 : p.in[9] + (size_t)idx * 1024 * 1024; dst = LW_WOUT; }
            else if (m == 2) { N = DFF; src = p.in[18] + (size_t)l * 1024 * DFF; gk = p.in[2] + (l * 4 + 2) * 1024; dst = LW_WGU; mode = 1; }
            else if (m == 3) { N = DFF; src = p.in[19] + (size_t)l * 1024 * DFF; gk = p.in[2] + (l * 4 + 2) * 1024; dst = LW_WGU; mode = 2; }
            else { K = DFF; src = p.in[20] + (size_t)l * DFF * 1024; dst = LW_WD; }
            const int nkt = K / 64, nnt = N / 64, ntile = nkt * nnt;
            int first = BID() - (base % GDIM()); if (first < 0) first += GDIM();
            for (int t = first; t < ntile; t += GDIM()) {
                const int kt = t % nkt, ntl = t / nkt; const int n0 = ntl * 64;
                int nrow0 = n0; if (mode) nrow0 = (n0 / 128) * 256 + (n0 % 128) + (mode == 2 ? 128 : 0);
                transpose_tile(src, N, kt * 64, n0, ws_w(p, l, dst), K, nrow0, gk, tile);
            }
            base += ntile;
        }
    }
    { bf16_t* rgw = (bf16_t*)(p.ws + WS_RGW);
      for (int e = BID() * NTHR + tid; e < 2 * 2 * 2 * 8 * 4096; e += GDIM() * NTHR) {
          const int c = e & 63, d = (e >> 6) & 63, blk = (e >> 12) & 7, ax = (e >> 15) & 1, dir = (e >> 16) & 1, idx = e >> 17;
          const float* src = ax ? p.in[14] : p.in[12];
          rgw[e] = f2bf(src[(((size_t)(idx * 2 + dir) * 8 + blk) * 64 + c) * 64 + d] * -1.44269504f); } }
    { const int wid = tid >> 6, lane = tid & 63; bf16_t* hb = ws_hb(p); float* rsv = ws_rs(p);
      for (int row = BID() * 8 + wid; row < NTOK; row += GDIM() * 8) {
          const float* xr = xin_row(p, row); f32x4 v[4]; float ss = 0.f;
#pragma unroll
          for (int i = 0; i < 4; ++i) { v[i] = *(const f32x4*)(xr + i * 256 + lane * 4); ss += v[i][0] * v[i][0] + v[i][1] * v[i][1] + v[i][2] * v[i][2] + v[i][3] * v[i][3]; }
          ss = wave_sum(ss); if (lane == 0) rsv[row] = rsqrtf(ss * (1.0f / 1024.0f) + 1e-6f);
#pragma unroll
          for (int i = 0; i < 4; ++i) { u32x2 w; w.x = cvt_pk_bf16(v[i][0], v[i][1]); w.y = cvt_pk_bf16(v[i][2], v[i][3]); *(u32x2*)(hb + (size_t)row * DM + i * 256 + lane * 4) = w; } } }
}

__device__ __forceinline__ void phase_rowpass(const Params& p, int layer, int which  ) {
    const int tid = TID(), wid = tid >> 6, lane = tid & 63;
    const bf16_t* Y = ws_y(p); bf16_t* xb = ws_hb(p); float* rsv = ws_rs(p);
    const float* gp = p.in[2] + (layer * 4 + (which ? 3 : 1)) * 1024;
    const bool last = (layer == 3 && which == 1);
    float gv[2][8];
#pragma unroll
    for (int i = 0; i < 2; ++i)
#pragma unroll
        for (int e = 0; e < 8; ++e) gv[i][e] = gp[i * 512 + lane * 8 + e];
    for (int row = BID() * 8 + wid; row < NTOK; row += GDIM() * 8) {
        float xv[2][8], yv[2][8]; float ssy = 0.f;
#pragma unroll
        for (int i = 0; i < 2; ++i) { const bf16x8 xw = *(const bf16x8*)(xb + (size_t)row * DM + i * 512 + lane * 8), yw = *(const bf16x8*)(Y + (size_t)row * DM + i * 512 + lane * 8);
#pragma unroll
            for (int e = 0; e < 8; ++e) { xv[i][e] = bf2f((bf16_t)xw[e]); yv[i][e] = bf2f((bf16_t)yw[e]); ssy += yv[i][e] * yv[i][e]; } }
        ssy = wave_sum(ssy); const float rsy = rsqrtf(ssy * (1.0f / 1024.0f) + 1e-6f);
        float ssx = 0.f;
#pragma unroll
        for (int i = 0; i < 2; ++i)
#pragma unroll
            for (int e = 0; e < 8; ++e) { xv[i][e] = xv[i][e] + yv[i][e] * rsy * gv[i][e]; ssx += xv[i][e] * xv[i][e]; }
        if (last) {
#pragma unroll
            for (int i = 0; i < 2; ++i) { float* op = p.out + (size_t)row * DM + i * 512 + lane * 8;
                *(f32x4*)op = (f32x4){xv[i][0], xv[i][1], xv[i][2], xv[i][3]}; *(f32x4*)(op + 4) = (f32x4){xv[i][4], xv[i][5], xv[i][6], xv[i][7]}; }
        } else {
            ssx = wave_sum(ssx); if (lane == 0) rsv[row] = rsqrtf(ssx * (1.0f / 1024.0f) + 1e-6f);
#pragma unroll
            for (int i = 0; i < 2; ++i) { u32x4 w; w.x = cvt_pk_bf16(xv[i][0], xv[i][1]); w.y = cvt_pk_bf16(xv[i][2], xv[i][3]); w.z = cvt_pk_bf16(xv[i][4], xv[i][5]); w.w = cvt_pk_bf16(xv[i][6], xv[i][7]);
                *(u32x4*)(xb + (size_t)row * DM + i * 512 + lane * 8) = w; }
        }
    }
}

__device__ __forceinline__ void phase_gemm(const Params& p, unsigned char* lds, int layer, int which  ) {
    const bool even = (layer & 1) == 0;
    pg8::Gemm g; g.M = NTOK; pg8::StaticOrder S;
    LAS unsigned char* l3 = (LAS unsigned char*)lds;
    if (which == 2) { g.A = ws_hb(p); g.Bt = ws_w(p, layer, LW_WGU); g.N = 2 * DFF; g.K = 1024; S.init(g.M, g.N, GDIM(), BID());
        pg8::EpiSwiGLU E{ws_big(p), DFF, ws_rs(p)}; pg8::gemm_phase(l3, g, S, E); }
    else { pg8::EpiStore E;
        if (which == 0) { g.A = ws_hb(p); g.Bt = ws_w(p, layer, LW_WIN); g.N = even ? ZLD_E : ZLD_O; g.K = 1024; E.O = ws_big(p); E.ldc = g.N; E.rs = ws_rs(p); }
        else if (which == 1) { g.A = ws_mx(p); g.Bt = ws_w(p, layer, LW_WOUT); g.N = 1024; g.K = 1024; E.O = ws_y(p); E.ldc = 1024; E.rs = nullptr; }
        else { g.A = ws_big(p); g.Bt = ws_w(p, layer, LW_WD); g.N = 1024; g.K = DFF; E.O = ws_y(p); E.ldc = 1024; E.rs = nullptr; }
        S.init(g.M, g.N, GDIM(), BID()); pg8::gemm_phase(l3, g, S, E); }
}

__device__ __forceinline__ void stage_vt(bf16_t* vt, const bf16x8 (&v)[4], int lane) {
#pragma unroll
    for (int i = 0; i < 4; ++i) { const int key = (lane >> 3) + 8 * i; *(bf16x8*)(vt + key * 80 + (lane & 7) * 8) = v[i]; }
}
typedef short s16x4 __attribute__((ext_vector_type(4)));
__device__ __forceinline__ bf16x8 read_vT(const bf16_t* vt, int dt, int lane) {
    const int fr = lane & 15, g = lane >> 4, q = fr >> 2, pq = fr & 3;
    const bf16_t* a0 = vt + (4 * g + q) * 80 + 16 * dt + 4 * pq;
    const s16x4 lo = __builtin_amdgcn_ds_read_tr16_b64_v4i16((LAS s16x4*)a0);
    const s16x4 hi = __builtin_amdgcn_ds_read_tr16_b64_v4i16((LAS s16x4*)(a0 + 16 * 80));
    return __builtin_shufflevector(lo, hi, 0, 1, 2, 3, 4, 5, 6, 7);
}

constexpr float LOG2E = 1.44269504f, LN2 = 0.69314718f;
__device__ __forceinline__ void na_wave(const Params& p, const float* rpbs  , bf16_t* vt, int seq, int r, int h, int gq, int lane) {
    const int fr = lane & 15, g = lane >> 4;
    const int c0 = gq == 0 ? 0 : (gq == 1 ? 8 : (gq == 2 ? 24 : 32));
    const int kr0 = min(max(r - 4, 0), 56);
    const int c = 16 * gq + fr, cs = min(max(c - 8, 0), 48);
    const bf16_t* zb = ws_big(p) + ((size_t)seq * SEQ + kr0 * 64 + c0) * ZLD_E + h * 64;
    const unsigned qoff = (unsigned)((r - kr0) * 64 + 16 * gq - c0 + fr) * ZLD_E + 8u * g;
    const bf16x8 q0 = *(const bf16x8*)(zb + qoff), q1 = *(const bf16x8*)(zb + qoff + 32);
    const unsigned koff = (unsigned)fr * ZLD_E + 512u + 8u * g;
    f32x4 s[16];
#pragma unroll
    for (int t = 0; t < 16; ++t) { const int kr = t >> 1, hf = t & 1;
        const bf16_t* kp = zb + (koff + (unsigned)((kr * 64 + 16 * hf) * ZLD_E));
        const bf16x8 k0 = *(const bf16x8*)kp, k1 = *(const bf16x8*)(kp + 32);
        f32x4 a = (f32x4){0.f, 0.f, 0.f, 0.f}; a = mfma16(k0, q0, a); a = mfma16(k1, q1, a); s[t] = a; }
    const unsigned voff = (unsigned)(lane >> 3) * ZLD_E + 1024u + 8u * (lane & 7);
    bf16x8 vb3[3][4];
#pragma unroll
    for (int kk2 = 0; kk2 < 2; ++kk2)
#pragma unroll
        for (int i = 0; i < 4; ++i) vb3[kk2][i] = *(const bf16x8*)(zb + (voff + (unsigned)((kk2 * 64 + 8 * i) * ZLD_E)));
    const float* rp = rpbs + (h * 15 + kr0 - r + 7) * 31 + (c0 - 16 * gq + 4 * g - fr + 15);
    const int mk = c0 + 4 * g - cs;
    float m = -1e30f;
#pragma unroll
    for (int t = 0; t < 16; ++t) { const int kr = t >> 1, hf = t & 1;
#pragma unroll
        for (int j = 0; j < 4; ++j) { const bool ok = (unsigned)(mk + 16 * hf + j) < 16u;
            float v = s[t][j] * (0.125f * LOG2E) + rp[kr * 31 + 16 * hf + j]; v = ok ? v : -1e30f; s[t][j] = v; m = fmaxf(m, v); } }
    m = fmaxf(m, __shfl_xor(m, 16)); m = fmaxf(m, __shfl_xor(m, 32));
    float l = 0.f;
#pragma unroll
    for (int t = 0; t < 16; ++t)
#pragma unroll
        for (int j = 0; j < 4; ++j) { const float e = __builtin_amdgcn_exp2f(s[t][j] - m); s[t][j] = e; l += e; }
    l += __shfl_xor(l, 16); l += __shfl_xor(l, 32);
    f32x4 o[4];
#pragma unroll
    for (int dt = 0; dt < 4; ++dt) o[dt] = (f32x4){0.f, 0.f, 0.f, 0.f};
#pragma unroll
    for (int kr = 0; kr < 8; ++kr) {
        if (kr + 2 < 8) {
#pragma unroll
            for (int i = 0; i < 4; ++i) vb3[(kr + 2) % 3][i] = *(const bf16x8*)(zb + (voff + (unsigned)(((kr + 2) * 64 + 8 * i) * ZLD_E))); }
        WAVE_SYNC();
        stage_vt(vt, vb3[kr % 3], lane);
        WAVE_SYNC();
        const bf16x8 pb = pack8(s[2 * kr], s[2 * kr + 1]);
#pragma unroll
        for (int dt = 0; dt < 4; ++dt) { const bf16x8 va = read_vT(vt, dt, lane); o[dt] = mfma16(va, pb, o[dt]); }
    }
    const float inv = __builtin_amdgcn_rcpf(l);
    bf16_t* mb = ws_mx(p) + ((size_t)seq * SEQ + r * 64 + 16 * gq) * DM + h * 64;
    const unsigned ooff = (unsigned)fr * DM + 4u * g;
#pragma unroll
    for (int dt = 0; dt < 4; ++dt) { u32x2 w; w.x = cvt_pk_bf16(o[dt][0] * inv, o[dt][1] * inv); w.y = cvt_pk_bf16(o[dt][2] * inv, o[dt][3] * inv); *(u32x2*)(mb + (ooff + 16u * dt)) = w; }
}

constexpr int HG_QLD = 136, HG_TLD = 72;
__device__ __forceinline__ void hgrn_item(const Params& p, unsigned char* lds, int lidx, int item) {
    const int tid = TID(), wid = tid >> 6, lane = tid & 63, fr = lane & 15, g = lane >> 4;
    const int seq = item >> 3, dir = (item >> 2) & 1, head = item & 3;
    bf16_t* QA = (bf16_t*)lds; bf16_t* QS = QA + 64 * HG_QLD; bf16_t* KT = QS + 64 * HG_QLD; bf16_t* KH = KT + 64 * HG_QLD; bf16_t* VT = KH + 128 * HG_TLD; bf16_t* AM = VT + 128 * HG_TLD;
    float* BC = (float*)(AM + 64 * HG_TLD); float* QT = BC + 128;
    const bf16_t* Z = ws_big(p);
    const int d = tid & 127, tq = tid >> 7, ch = head * 128 + d;
    float lb = 0.f;
    if (lidx == 1) { const float l0 = p.in[6][(0 * 2 + dir) * 512 + ch], l1 = p.in[6][(1 * 2 + dir) * 512 + ch]; lb = 1.0f / (1.0f + expf(l0 - l1)); }
    const float oml = 1.0f - lb;
    f32x4 st[8];
#pragma unroll
    for (int i = 0; i < 8; ++i) st[i] = (f32x4){0.f, 0.f, 0.f, 0.f};
    bf16_t* Od = dir == 0 ? ws_mx(p) + 512 : ws_hgb(p); const int ldo = dir == 0 ? DM : 512;
    const size_t tokb = (size_t)seq * SEQ;
    const int zcol = (dir ? 2560 : 2048) + ch;
#define LDS_BAR() do { asm volatile("s_waitcnt lgkmcnt(0)" ::: "memory"); __builtin_amdgcn_s_barrier(); asm volatile("" ::: "memory"); } while (0)
    bf16_t* RAW = (bf16_t*)(QT + 512);
#define HG_LOAD(ck_) do { const bf16_t* cb = Z + (tokb + (size_t)(dir == 0 ? (ck_) * 64 : SEQ - 64 - (ck_) * 64)) * ZLD_E;     \
        _Pragma("unroll") for (int k2 = 0; k2 < 2; ++k2) { const int id = tid + 512 * k2; const int rr = id >> 4, c8 = (id & 15) * 8; \
        const unsigned ro = (unsigned)(dir == 0 ? rr : 63 - rr) * ZLD_E + (unsigned)(head * 128 + c8); \
        rawr[0][k2] = *(const u32x4*)(cb + ro + 1536u); rawr[1][k2] = *(const u32x4*)(cb + ro + (dir ? 2560u : 2048u)); rawr[2][k2] = *(const u32x4*)(cb + ro + 3072u); } } while (0)
    u32x4 rawr[3][2];
    HG_LOAD(0);
    for (int ck = 0; ck < 64; ++ck) {
        float lf[16], qv[16], kk[16]; unsigned cv[8];
#pragma unroll
        for (int k2 = 0; k2 < 2; ++k2) { const int id = tid + 512 * k2; const int rr = id >> 4, c8 = (id & 15) * 8;
#pragma unroll
            for (int a = 0; a < 3; ++a) *(u32x4*)(RAW + (a * 64 + rr) * HG_QLD + c8) = rawr[a][k2]; }
        LDS_BAR();
        if (ck + 1 < 64) HG_LOAD(ck + 1);
#pragma unroll
        for (int e = 0; e < 16; ++e) { const int i = 16 * tq + e;
            const float q = bf2f(RAW[(0 * 64 + i) * HG_QLD + d]), z = bf2f(RAW[(1 * 64 + i) * HG_QLD + d]);
            const float ez = fexp(-z), sg = __builtin_amdgcn_rcpf(1.0f + ez); const float f = lb + oml * sg;
            lf[e] = __builtin_amdgcn_logf(f); kk[e] = 1.0f - f;     qv[e] = q * __builtin_amdgcn_rcpf(1.0f + fexp(-q)); }
#pragma unroll
        for (int e2 = 0; e2 < 8; ++e2) { const int i = 16 * tq + 2 * e2; cv[e2] = (unsigned)RAW[(2 * 64 + i) * HG_QLD + d] | ((unsigned)RAW[(2 * 64 + i + 1) * HG_QLD + d] << 16); }
#pragma unroll
        for (int e = 1; e < 16; ++e) lf[e] += lf[e - 1];
        QT[tq * 128 + d] = lf[15];
        LDS_BAR();
        const float t0 = QT[d], t1 = QT[128 + d], t2 = QT[256 + d], t3 = QT[384 + d];
        const float off = tq == 0 ? 0.f : (tq == 1 ? t0 : (tq == 2 ? t0 + t1 : t0 + t1 + t2));
        const float bref = t0 + t1, bC = t0 + t1 + t2 + t3;
        const float eref = __builtin_amdgcn_exp2f(bref), ecr = __builtin_amdgcn_exp2f(bC - bref);
        float kh[16];
        const float offr = off - bref;
#pragma unroll
        for (int e = 0; e < 16; ++e) { const int i = 16 * tq + e;
            const float e1 = __builtin_amdgcn_exp2f(fminf(fmaxf(lf[e] + offr, -115.f), 115.f)); const float r1 = __builtin_amdgcn_rcpf(e1);
            QA[i * HG_QLD + d] = f2bf(qv[e] * e1); QS[i * HG_QLD + d] = f2bf(qv[e] * e1 * eref);
            KT[i * HG_QLD + d] = f2bf(kk[e] * r1); kh[e] = kk[e] * r1 * ecr; }
        { u32x4 w0, w1; w0.x = cvt_pk_bf16(kh[0], kh[1]); w0.y = cvt_pk_bf16(kh[2], kh[3]); w0.z = cvt_pk_bf16(kh[4], kh[5]); w0.w = cvt_pk_bf16(kh[6], kh[7]);
          w1.x = cvt_pk_bf16(kh[8], kh[9]); w1.y = cvt_pk_bf16(kh[10], kh[11]); w1.z = cvt_pk_bf16(kh[12], kh[13]); w1.w = cvt_pk_bf16(kh[14], kh[15]);
          *(u32x4*)(KH + d * HG_TLD + 16 * tq) = w0; *(u32x4*)(KH + d * HG_TLD + 16 * tq + 8) = w1;
          u32x4 x0, x1; x0.x = cv[0]; x0.y = cv[1]; x0.z = cv[2]; x0.w = cv[3]; x1.x = cv[4]; x1.y = cv[5]; x1.z = cv[6]; x1.w = cv[7];
          *(u32x4*)(VT + d * HG_TLD + 16 * tq) = x0; *(u32x4*)(VT + d * HG_TLD + 16 * tq + 8) = x1; }
        if (tq == 0) BC[d] = __builtin_amdgcn_exp2f(bC);
        LDS_BAR();
        { const int ti = wid >> 1, sj0 = 2 * (wid & 1);
          f32x4 a0 = (f32x4){0.f, 0.f, 0.f, 0.f}, a1 = a0;
#pragma unroll
          for (int ks = 0; ks < 4; ++ks) { const bf16x8 qa = *(const bf16x8*)(QA + (16 * ti + fr) * HG_QLD + 32 * ks + 8 * g);
              const bf16x8 kb0 = *(const bf16x8*)(KT + (16 * sj0 + fr) * HG_QLD + 32 * ks + 8 * g), kb1 = *(const bf16x8*)(KT + (16 * sj0 + 16 + fr) * HG_QLD + 32 * ks + 8 * g);
              a0 = mfma16(qa, kb0, a0); a1 = mfma16(qa, kb1, a1); }
#pragma unroll
          for (int j = 0; j < 4; ++j) { const int t = 16 * ti + 4 * g + j, s0 = 16 * sj0 + fr, s1 = s0 + 16;
              AM[t * HG_TLD + s0] = f2bf(s0 <= t ? a0[j] : 0.f); AM[t * HG_TLD + s1] = f2bf(s1 <= t ? a1[j] : 0.f); } }
        LDS_BAR();
        bf16_t* ob = Od + (tokb + (size_t)(dir == 0 ? ck * 64 : SEQ - 64 - ck * 64)) * ldo;
        bf16x8 vb[2];
#pragma unroll
        for (int ks = 0; ks < 2; ++ks) vb[ks] = *(const bf16x8*)(VT + (16 * wid + fr) * HG_TLD + 32 * ks + 8 * g);
        bf16x8 sb[4];
#pragma unroll
        for (int pp = 0; pp < 4; ++pp) sb[pp] = pack8(st[2 * pp], st[2 * pp + 1]);
#pragma unroll
        for (int ti = 0; ti < 4; ++ti) {
            f32x4 o = (f32x4){0.f, 0.f, 0.f, 0.f};
#pragma unroll
            for (int ks = 0; ks < 2; ++ks) { const bf16x8 am = *(const bf16x8*)(AM + (16 * ti + fr) * HG_TLD + 32 * ks + 8 * g); o = mfma16(am, vb[ks], o); }
#pragma unroll
            for (int pp = 0; pp < 4; ++pp) { const bf16x4 lo = *(const bf16x4*)(QS + (16 * ti + fr) * HG_QLD + 32 * pp + 4 * g), hi = *(const bf16x4*)(QS + (16 * ti + fr) * HG_QLD + 32 * pp + 16 + 4 * g);
                const bf16x8 qs = __builtin_shufflevector(lo, hi, 0, 1, 2, 3, 4, 5, 6, 7); o = mfma16(qs, sb[pp], o); }
#pragma unroll
            for (int j = 0; j < 4; ++j) { const int i = 16 * ti + 4 * g + j;
                ob[(unsigned)(dir == 0 ? i : 63 - i) * (unsigned)ldo + (unsigned)(head * 128 + 16 * wid + fr)] = f2bf(o[j]); }
        }
#pragma unroll
        for (int i = 0; i < 8; ++i) { const f32x4 dec = *(const f32x4*)(BC + 16 * i + 4 * g); st[i] = st[i] * dec;
#pragma unroll
            for (int ks = 0; ks < 2; ++ks) { const bf16x8 khv = *(const bf16x8*)(KH + (16 * i + fr) * HG_TLD + 32 * ks + 8 * g); st[i] = mfma16(khv, vb[ks], st[i]); } }
        LDS_BAR();
    }
}
static_assert((3 * 64 * HG_QLD + 2 * 128 * HG_TLD + 64 * HG_TLD) * 2 + (128 + 512) * 4 + 3 * 64 * HG_QLD * 2 <= LDS_BYTES, "hgrn lds");

__device__ __forceinline__ void phase_even_mix(const Params& p, unsigned char* lds, int lidx) {
    const int tid = TID(), wid = __builtin_amdgcn_readfirstlane(tid >> 6), lane = tid & 63;
    for (int rep = 0; rep < ((DBG_REP & 8) ? 2 : 1); ++rep)
    for (int item = BID(); item < 160; item += GDIM()) hgrn_item(p, lds, lidx, item);
    __syncthreads();
    float* rpbs = (float*)lds + 64; bf16_t* vt = (bf16_t*)(lds + 16384) + wid * (64 * 40); int* slot = (int*)(lds + 15872);
    const float* rpb = p.in[5] + (size_t)lidx * 8 * 15 * 31;
    for (int i = tid; i < 8 * 15 * 31; i += NTHR) rpbs[i] = rpb[i] * LOG2E;
    unsigned* ctrs = (unsigned*)(p.ws + WS_CTL) + 16 + lidx * 8;
    const unsigned xcc = ((unsigned)__builtin_amdgcn_s_getreg((3 << 11) | 20)) & 7u;
    for (unsigned kq = 0; kq < 8; ++kq) { const unsigned q = (xcc + kq) & 7u;
        for (;;) {
            __syncthreads();
            if (tid == 0) *slot = (int)atomicAdd(ctrs + q, 1u);
            __syncthreads();
            const int j = __builtin_amdgcn_readfirstlane(*slot);
            if (j >= 10 * 64) break;
            const int pi = (int)q + 8 * (j >> 6), r = j & 63, seq = pi >> 2, hp = pi & 3;
            na_wave(p, rpbs, vt, seq, r, 2 * hp + (wid >> 2), wid & 3, lane);
        } }
}

__device__ __forceinline__ void phase_hgrn_fin(const Params& p, int lidx) {
    const int tid = TID(), wid = tid >> 6, lane = tid & 63;
    const bf16_t* Z = ws_big(p); bf16_t* Mx = ws_mx(p); const bf16_t* Ob = ws_hgb(p);
    const float* on = p.in[7] + lidx * 128 + (lane & 15) * 8;
    float gn[8];
#pragma unroll
    for (int e = 0; e < 8; ++e) gn[e] = on[e];
    for (int row = BID() * 8 + wid; row < NTOK; row += GDIM() * 8) {
        const bf16x8 a = *(const bf16x8*)(Mx + (size_t)row * DM + 512 + lane * 8), b = *(const bf16x8*)(Ob + (size_t)row * 512 + lane * 8), gz = *(const bf16x8*)(Z + (size_t)row * ZLD_E + 3584 + lane * 8);
        float o[8]; float ss = 0.f;
#pragma unroll
        for (int e = 0; e < 8; ++e) { o[e] = bf2f((bf16_t)a[e]) + bf2f((bf16_t)b[e]); ss += o[e] * o[e]; }
        ss += __shfl_xor(ss, 1); ss += __shfl_xor(ss, 2); ss += __shfl_xor(ss, 4); ss += __shfl_xor(ss, 8);
        const float rs = rsqrtf(ss * (1.0f / 128.0f) + 1e-6f);
        float r[8];
#pragma unroll
        for (int e = 0; e < 8; ++e) r[e] = o[e] * rs * gn[e] * siluf_(bf2f((bf16_t)gz[e]));
        u32x4 w; w.x = cvt_pk_bf16(r[0], r[1]); w.y = cvt_pk_bf16(r[2], r[3]); w.z = cvt_pk_bf16(r[4], r[5]); w.w = cvt_pk_bf16(r[6], r[7]);
        *(u32x4*)(Mx + (size_t)row * DM + 512 + lane * 8) = w;
    }
}

constexpr int RG_YLD = 72, RG_ALD = 68, RG_WAVE_LDS = 64 * RG_YLD * 2 + 2 * 16 * RG_ALD * 4;
static_assert(8 * RG_WAVE_LDS <= LDS_BYTES, "rg lds");
__device__ __forceinline__ float gelu_tanh(float x) { const float w = __builtin_fmaf(x * x, -0.102943246f, -2.30220819f);
    return x * __builtin_amdgcn_rcpf(1.0f + __builtin_amdgcn_exp2f(x * w)); }
template <int MODE>
__device__ __forceinline__ void rg_wave(const Params& p, unsigned char* wl, int idx, int seq, int ck, int blk, int lane) {
    const int fr = lane & 15, g = lane >> 4;
    bf16_t* ybf = (bf16_t*)wl; float* auA = (float*)(wl + 64 * RG_YLD * 2); float* auU = auA + 16 * RG_ALD;
    const bf16_t* Z = ws_big(p); bf16_t* Mx = ws_mx(p);
    float* SA = (float*)(p.ws + WS_RGS); float* SH = SA + RGS_ONE / 4; const float* HI = SH + RGS_ONE / 4;
    const size_t tokb = (size_t)seq * SEQ; const int t0 = ck * 64, ch = blk * 64 + lane;
    {
      const float* cw = p.in[10] + idx * 4 * 512; const float w0 = cw[ch], w1 = cw[512 + ch], w2 = cw[1024 + ch], w3 = cw[1536 + ch], cb = p.in[11][idx * 512 + ch];
      const bf16_t* xb = Z + tokb * ZLD_O + 512 + blk * 64;
      u32x4 xr[9];
#pragma unroll
      for (int k = 0; k < 9; ++k) { const int pc = lane + 64 * k; const int rr = pc >> 3, c8 = (pc & 7) * 8; const int t = t0 - 2 + rr;
          xr[k] = (u32x4){0u, 0u, 0u, 0u};
          if (pc < 67 * 8 && t >= 0 && t < SEQ) xr[k] = *(const u32x4*)(xb + (size_t)t * ZLD_O + c8); }
#pragma unroll
      for (int k = 0; k < 9; ++k) { const int pc = lane + 64 * k; const int rr = pc >> 3, c8 = (pc & 7) * 8; if (pc < 67 * 8) *(u32x4*)(ybf + rr * RG_YLD + c8) = xr[k]; }
      WAVE_SYNC();
      float xm2 = bf2f(ybf[0 * RG_YLD + lane]), xm1 = bf2f(ybf[1 * RG_YLD + lane]), x0 = bf2f(ybf[2 * RG_YLD + lane]);
#pragma unroll 8
      for (int t = 0; t < 64; ++t) { const float x1 = bf2f(ybf[(t + 3) * RG_YLD + lane]); const float y = w0 * xm2 + w1 * xm1 + w2 * x0 + w3 * x1 + cb;
          ybf[t * RG_YLD + lane] = f2bf(y); xm2 = xm1; xm1 = x0; x0 = x1; }
    }
    WAVE_SYNC();
    const bf16_t* rgw = (const bf16_t*)(p.ws + WS_RGW) + (size_t)idx * 131072;
    const bf16_t* zgb = Z + (tokb + t0) * ZLD_O + blk * 64; bf16_t* mxb = Mx + (tokb + t0) * DM + blk * 64;
#pragma unroll
    for (int dir = 0; dir < 2; ++dir) {
        const bf16_t* wa_ = rgw + ((dir * 2 + 0) * 8 + blk) * 4096; const bf16_t* wx_ = rgw + ((dir * 2 + 1) * 8 + blk) * 4096;
        bf16x8 wa[4][2], wx[4][2]; float ba[4], bx[4], sp8[4];
#pragma unroll
        for (int n = 0; n < 4; ++n) {
#pragma unroll
            for (int ks = 0; ks < 2; ++ks) { wa[n][ks] = *(const bf16x8*)(wa_ + (16 * n + fr) * 64 + 32 * ks + 8 * g); wx[n][ks] = *(const bf16x8*)(wx_ + (16 * n + fr) * 64 + 32 * ks + 8 * g); }
            const int chn = (idx * 2 + dir) * 512 + blk * 64 + 16 * n + fr; ba[n] = p.in[13][chn] * -1.44269504f; bx[n] = p.in[15][chn] * -1.44269504f; sp8[n] = -8.0f * 1.44269504f * log1pf(expf(-p.in[16][chn])); }
        const int sidx = ((seq * 64 + ck) * 2 + dir) * 512 + ch;
        float h = 0.f, P = 1.f; if (MODE == 1) h = HI[sidx];
        const int first = dir ? SEQ - 1 : 0;
#pragma unroll 1
        for (int tti = 0; tti < 4; ++tti) { const int tt = dir ? 3 - tti : tti;
            const bool has_first = __builtin_amdgcn_readfirstlane((int)((unsigned)(first - (t0 + 16 * tt)) < 16u)) != 0;
            bf16x8 ya[2];
#pragma unroll
            for (int ks = 0; ks < 2; ++ks) ya[ks] = *(const bf16x8*)(ybf + (16 * tt + fr) * RG_YLD + 32 * ks + 8 * g);
#define RG_ELEMS(FIRSTCHK) do { _Pragma("unroll") for (int n = 0; n < 4; ++n) { f32x4 ar = (f32x4){ba[n], ba[n], ba[n], ba[n]}, ai = (f32x4){bx[n], bx[n], bx[n], bx[n]};     \
                _Pragma("unroll") for (int ks = 0; ks < 2; ++ks) { ar = mfma16(ya[ks], wa[n][ks], ar); ai = mfma16(ya[ks], wx[n][ks], ai); } \
                _Pragma("unroll") for (int j = 0; j < 4; ++j) { const int tok = 16 * tt + 4 * g + j; const float yv = bf2f(ybf[tok * RG_YLD + 16 * n + fr]); \
                    const float r = __builtin_amdgcn_rcpf(1.0f + __builtin_amdgcn_exp2f(ar[j])), ii = __builtin_amdgcn_rcpf(1.0f + __builtin_amdgcn_exp2f(ai[j])); \
                    const float a = __builtin_amdgcn_exp2f(r * sp8[n]);       \
                    const float em = __builtin_fmaf(-a, a, 1.0f);              \
                    float sc = __builtin_amdgcn_sqrtf(em); if (FIRSTCHK) { if (t0 + tok == first) sc = 1.0f; } \
                    auA[(4 * g + j) * RG_ALD + 16 * n + fr] = a; auU[(4 * g + j) * RG_ALD + 16 * n + fr] = sc * ii * yv; } } } while (0)
            if (has_first) RG_ELEMS(true); else RG_ELEMS(false);
#undef RG_ELEMS
            WAVE_SYNC();
            bf16_t gcv[16], pv[16];
            const unsigned zo = (unsigned)(16 * tt * ZLD_O) + (unsigned)lane, mo = (unsigned)(16 * tt * DM) + (unsigned)lane;
            if (MODE == 1 && dir == 1) {
#pragma unroll
                for (int s = 0; s < 16; ++s) { gcv[s] = zgb[zo + (unsigned)(s * ZLD_O)]; pv[s] = mxb[mo + (unsigned)(s * DM)]; } }
#pragma unroll
            for (int si = 0; si < 16; ++si) { const int s = dir ? 15 - si : si; const float a = auA[s * RG_ALD + lane], u = auU[s * RG_ALD + lane]; h = a * h + u; P *= a;
                if (MODE == 1) { if (dir == 0) mxb[mo + (unsigned)(s * DM)] = f2bf(h); else mxb[mo + (unsigned)(s * DM)] = f2bf((bf2f(pv[s]) + h) * gelu_tanh(bf2f(gcv[s]))); } }
            WAVE_SYNC();
        }
        if (MODE == 0) { SA[sidx] = P; SH[sidx] = h; }
    }
}

__device__ __forceinline__ void phase_rg_carry(const Params& p) {
    float* SA = (float*)(p.ws + WS_RGS); float* SH = SA + RGS_ONE / 4; float* HI = SH + RGS_ONE / 4;
    for (int e = BID() * NTHR + TID(); e < NSEQ * 2 * 512; e += GDIM() * NTHR) { const int ch = e & 511, dir = (e >> 9) & 1, seq = e >> 10;
        float H = 0.f;
        for (int i = 0; i < 64; ++i) { const int ck = dir ? 63 - i : i; const int sidx = ((seq * 64 + ck) * 2 + dir) * 512 + ch; HI[sidx] = H; H = SA[sidx] * H + SH[sidx]; } }
}

constexpr int DL_OB = 0, DL_LSE = 3 * 256 * 64 * 2, DL_TB = DL_LSE + 3 * 256 * 4, DL_VT = DL_TB + 2048, DL_END = DL_VT + 8 * 64 * 40 * 2;
static_assert(DL_END <= LDS_BYTES, "dil lds");
struct DilTile { int br, dsh, L, res, jj0; };
__device__ __forceinline__ DilTile dil_tile(int it, int blk) { DilTile t; t.br = it >> 4; const int ti = it & 15; t.dsh = 2 * t.br; t.L = SEQ >> t.dsh;
    if (t.br == 0) { t.res = 0; t.jj0 = blk * 256 + 16 * ti; } else if (t.br == 1) { t.res = ti >> 2; t.jj0 = blk * 64 + 16 * (ti & 3); } else { t.res = ti; t.jj0 = blk * 16; }
    return t; }
__device__ __forceinline__ void dil_item(const Params& p, unsigned char* lds, int seq, int blk, int h) {
    const int tid = TID(), wid = __builtin_amdgcn_readfirstlane(tid >> 6), lane = tid & 63, fr = lane & 15, g = lane >> 4;
    bf16_t* OB = (bf16_t*)(lds + DL_OB); float* LSE = (float*)(lds + DL_LSE); float* TB = (float*)(lds + DL_TB); bf16_t* vt = (bf16_t*)(lds + DL_VT) + wid * (64 * 40);
    for (int i = tid; i < 3 * 160; i += NTHR) { const int b3 = i / 160, rel = i % 160 - 79;
        TB[i] = (rel >= -64 && rel <= 64) ? p.in[17][(int)T5_BUCKET[b3 * 129 + rel + 64] * 8 + h] * LOG2E : -1e30f; }
    __syncthreads();
    const bf16_t* Z = ws_big(p); bf16_t* Mx = ws_mx(p);
    const size_t tokb = (size_t)seq * SEQ;
    const bf16_t* zq = Z + tokb * ZLD_O + h * 64;
#define DIL_KQLOAD(T) do { const bf16_t* zr_ = zq + T.res * ZLD_O; const unsigned qo_ = (unsigned)((T.jj0 + fr) << T.dsh) * ZLD_O + 1024u + 8u * g; qf[0] = *(const bf16x8*)(zr_ + qo_); qf[1] = *(const bf16x8*)(zr_ + qo_ + 32); \
        _Pragma("unroll") for (int pq_ = 0; pq_ < 5; ++pq_) _Pragma("unroll") for (int i = 0; i < 4; ++i) { const int key = (lane >> 3) + 8 * i; const int kjj_ = min(max(T.jj0 - 64 + 32 * pq_ + key, 0), T.L - 1); \
            if (pq_ == 4 && i >= 2) kst[pq_][i] = (bf16x8){0, 0, 0, 0, 0, 0, 0, 0}; \
            else kst[pq_][i] = *(const bf16x8*)(zr_ + ((unsigned)(kjj_ << T.dsh) * ZLD_O + 1536u + 8u * (lane & 7))); } } while (0)
#define DIL_VLOAD(dst, T, pp_) do { const bf16_t* zr_ = zq + T.res * ZLD_O; _Pragma("unroll") for (int i = 0; i < 4; ++i) { const int key = (lane >> 3) + 8 * i; const int kjj_ = min(max(T.jj0 - 64 + 32 * (pp_) + key, 0), T.L - 1); \
            if ((pp_) == 4 && i >= 2) dst[i] = (bf16x8){0, 0, 0, 0, 0, 0, 0, 0};     \
            else dst[i] = *(const bf16x8*)(zr_ + ((unsigned)(kjj_ << T.dsh) * ZLD_O + 2048u + 8u * (lane & 7))); } } while (0)
    DilTile cur = dil_tile(wid, blk);
    bf16x8 qf[2], kst[5][4]; bf16x8 vb3[3][4];
    DIL_KQLOAD(cur); DIL_VLOAD(vb3[0], cur, 0); DIL_VLOAD(vb3[1], cur, 1);
#pragma unroll 1
    for (int it = wid; it < 48; it += 8) {
        const bool has_next = it + 8 < 48; const DilTile nxt = dil_tile(has_next ? it + 8 : it, blk);
        const int br = cur.br, dsh = cur.dsh, L = cur.L, res = cur.res, jj0 = cur.jj0;
        const int qtok = ((jj0 + fr) << dsh) + res;
        f32x4 s[10];
#pragma unroll
        for (int pq = 0; pq < 5; ++pq) {
            WAVE_SYNC();
            stage_vt(vt, kst[pq], lane);
            WAVE_SYNC();
#pragma unroll
            for (int tt = 0; tt < 2; ++tt) {
                if (pq == 4 && tt == 1) { s[9] = (f32x4){0.f, 0.f, 0.f, 0.f}; continue; }
                const bf16x8 k0 = *(const bf16x8*)(vt + (16 * tt + fr) * 80 + 8 * g), k1 = *(const bf16x8*)(vt + (16 * tt + fr) * 80 + 32 + 8 * g);
                f32x4 a = (f32x4){0.f, 0.f, 0.f, 0.f}; a = mfma16(k0, qf[0], a); a = mfma16(k1, qf[1], a); s[2 * pq + tt] = a; }
        }
        if (has_next) DIL_KQLOAD(nxt);
        const float* tbp = TB + br * 160 + (4 * g - fr + 15);
        float m = -1e30f;
#pragma unroll
        for (int kt = 0; kt < 9; ++kt)
#pragma unroll
            for (int j = 0; j < 4; ++j) s[kt][j] = s[kt][j] * (0.125f * LOG2E) + tbp[16 * kt + j];
        if (jj0 < 64 || jj0 + 80 > L) {
#pragma unroll
            for (int kt = 0; kt < 9; ++kt)
#pragma unroll
                for (int j = 0; j < 4; ++j) { const int kjj = jj0 - 64 + 16 * kt + 4 * g + j; s[kt][j] = (kjj >= 0 && kjj < L) ? s[kt][j] : -1e30f; } }
#pragma unroll
        for (int kt = 0; kt < 9; ++kt)
#pragma unroll
            for (int j = 0; j < 4; ++j) m = fmaxf(m, s[kt][j]);
        m = fmaxf(m, __shfl_xor(m, 16)); m = fmaxf(m, __shfl_xor(m, 32));
        float l = 0.f;
#pragma unroll
        for (int kt = 0; kt < 9; ++kt)
#pragma unroll
            for (int j = 0; j < 4; ++j) { const float e = __builtin_amdgcn_exp2f(s[kt][j] - m); s[kt][j] = e; l += e; }
        l += __shfl_xor(l, 16); l += __shfl_xor(l, 32);
        f32x4 o[4];
#pragma unroll
        for (int dt = 0; dt < 4; ++dt) o[dt] = (f32x4){0.f, 0.f, 0.f, 0.f};
#pragma unroll
        for (int pp = 0; pp < 5; ++pp) {
            if (pp + 2 < 5) DIL_VLOAD(vb3[(pp + 2) % 3], cur, pp + 2);
            WAVE_SYNC();
            stage_vt(vt, vb3[pp % 3], lane);
            WAVE_SYNC();
            if (pp == 3 && has_next) DIL_VLOAD(vb3[0], nxt, 0);
            if (pp == 4 && has_next) DIL_VLOAD(vb3[1], nxt, 1);
            const bf16x8 pb = pack8(s[2 * pp], s[2 * pp + 1]);
#pragma unroll
            for (int dt = 0; dt < 4; ++dt) { const bf16x8 va = read_vT(vt, dt, lane); o[dt] = mfma16(va, pb, o[dt]); }
        }
        const float inv = 1.0f / l; const int loc = qtok - blk * 256;
#pragma unroll
        for (int dt = 0; dt < 4; ++dt) { u32x2 w; w.x = cvt_pk_bf16(o[dt][0] * inv, o[dt][1] * inv); w.y = cvt_pk_bf16(o[dt][2] * inv, o[dt][3] * inv); *(u32x2*)(OB + (br * 256 + loc) * 64 + 16 * dt + 4 * g) = w; }
        if (g == 0) LSE[br * 256 + loc] = (m + __builtin_amdgcn_logf(l)) * LN2;
        cur = nxt;
    }
    __syncthreads();
    { const int tok = tid >> 1, hf = tid & 1; const float l0 = LSE[tok], l1 = LSE[256 + tok], l2 = LSE[512 + tok]; const float mx = fmaxf(l0, fmaxf(l1, l2));
      float w0 = __expf(l0 - mx), w1 = __expf(l1 - mx), w2 = __expf(l2 - mx); const float inv = 1.0f / (w0 + w1 + w2); w0 *= inv; w1 *= inv; w2 *= inv;
#pragma unroll
      for (int c = 0; c < 4; ++c) { const bf16x8 a0 = *(const bf16x8*)(OB + (0 * 256 + tok) * 64 + 32 * hf + 8 * c), a1 = *(const bf16x8*)(OB + (1 * 256 + tok) * 64 + 32 * hf + 8 * c), a2 = *(const bf16x8*)(OB + (2 * 256 + tok) * 64 + 32 * hf + 8 * c);
          float r[8];
#pragma unroll
          for (int e = 0; e < 8; ++e) r[e] = w0 * bf2f((bf16_t)a0[e]) + w1 * bf2f((bf16_t)a1[e]) + w2 * bf2f((bf16_t)a2[e]);
          u32x4 w; w.x = cvt_pk_bf16(r[0], r[1]); w.y = cvt_pk_bf16(r[2], r[3]); w.z = cvt_pk_bf16(r[4], r[5]); w.w = cvt_pk_bf16(r[6], r[7]);
          *(u32x4*)(Mx + (tokb + blk * 256 + tok) * DM + 512 + h * 64 + 32 * hf + 8 * c) = w; } }
    __syncthreads();
}

__device__ __forceinline__ void phase_odd_mix1(const Params& p, unsigned char* lds, int idx) {
    const int t_ = TID(); const int wid = __builtin_amdgcn_readfirstlane(t_ >> 6), lane = t_ & 63;
    if (!(DBG_SKIP & 4)) for (int it = BID(); it < NSEQ * 64; it += GDIM()) rg_wave<0>(p, lds + wid * RG_WAVE_LDS, idx, it >> 6, it & 63, wid, lane);
    __syncthreads();
    for (int rep = 0; rep < ((DBG_REP & 64) ? 2 : 1); ++rep)
    if (!(DBG_SKIP & 8)) for (int it = BID(); it < NSEQ * 16 * 8; it += GDIM()) dil_item(p, lds, it >> 7, (it >> 3) & 15, it & 7);
}
__device__ __forceinline__ void phase_odd_mix3(const Params& p, unsigned char* lds, int idx) {
    const int t_ = TID(); const int wid = __builtin_amdgcn_readfirstlane(t_ >> 6), lane = t_ & 63;
    if (!(DBG_SKIP & 4)) for (int it = BID(); it < NSEQ * 64; it += GDIM()) rg_wave<1>(p, lds + wid * RG_WAVE_LDS, idx, it >> 6, it & 63, wid, lane);
}

#define XB_TMO      128
#define XB_XCNT(j)  (256  + 64 * (j))
#define XB_XSUB(j)  (1280 + 64 * (j))
#define XB_XGEN(j)  (2304 + 64 * (j))
#define XB_TOP      3328
#define XB_TOPGEN   3392
#define XCD_BAR_WORDS 3456
#define XB_SPIN_CAP (1u << 22)
__device__ __forceinline__ unsigned xb_ld(unsigned* p)              { return __hip_atomic_load(p, __ATOMIC_RELAXED, __HIP_MEMORY_SCOPE_AGENT); }
__device__ __forceinline__ unsigned xb_add(unsigned* p, unsigned v) { return __hip_atomic_fetch_add(p, v, __ATOMIC_RELAXED, __HIP_MEMORY_SCOPE_AGENT); }
__device__ __forceinline__ unsigned xb_xcc_id() { return (unsigned)__builtin_amdgcn_s_getreg((3 << 11) | 20) & 0xFu; }
#define XB_SPIN(cond, bar) do { unsigned _sp = 0; while (cond) { __builtin_amdgcn_s_sleep(1); \
    if ((++_sp & 255u) == 0u) { if (xb_ld(&(bar)[XB_TMO])) break; if (_sp > XB_SPIN_CAP) { atomicAdd(&(bar)[XB_TMO], 1u); break; } } } } while (0)
struct XcdBarrier { unsigned* bar; unsigned x; volatile LAS unsigned* st; };
__device__ __forceinline__ XcdBarrier xcd_barrier_post(unsigned* bar, volatile LAS unsigned* st) {
    XcdBarrier b; b.bar = bar; b.x = xb_xcc_id(); b.st = st;
    if (threadIdx.x == 0) (void)xb_add(&bar[XB_XCNT(b.x)], 1u);
    return b;
}
__device__ __forceinline__ void xcd_barrier_complete(unsigned* bar, unsigned x, unsigned& nloc, unsigned& nx) {
    const unsigned G = gridDim.x * gridDim.y * gridDim.z;
    unsigned sum, cnt, mine, sp = 0u;
    for (;;) {
        sum = 0u; cnt = 0u; mine = 0u;
#pragma unroll
        for (unsigned j = 0; j < 16; ++j) { const unsigned c = xb_ld(&bar[XB_XCNT(j)]); sum += c; cnt += (c > 0u) ? 1u : 0u; mine = (j == x) ? c : mine; }
        if (sum == G) break;
        __builtin_amdgcn_s_sleep(1);
        if ((++sp & 255u) == 0u) { if (xb_ld(&bar[XB_TMO])) break; if (sp > XB_SPIN_CAP) { atomicAdd(&bar[XB_TMO], 1u); break; } }
    }
    nloc = mine > 0u ? mine : 1u; nx = cnt > 0u ? cnt : 1u;
}
__device__ __forceinline__ void xcd_barrier(const XcdBarrier& b) {
    asm volatile("s_waitcnt vmcnt(0)" ::: "memory");
    __syncthreads();
    if (threadIdx.x == 0) {
        unsigned* bar = b.bar;
        __builtin_amdgcn_s_waitcnt(0);
        unsigned nloc = b.st[0], nx = b.st[1];
        if (nloc == 0u) { xcd_barrier_complete(bar, b.x, nloc, nx); b.st[0] = nloc; b.st[1] = nx; }
        const unsigned old = xb_add(&bar[XB_XSUB(b.x)], 1u);
        const unsigned gen = old / nloc;
        if (old + 1u == (gen + 1u) * nloc) {
            __builtin_amdgcn_fence(__ATOMIC_RELEASE, "agent");
            asm volatile("s_waitcnt vmcnt(0)" ::: "memory");
            const unsigned og = xb_add(&bar[XB_TOP], 1u);
            const unsigned tg = og / nx;
            if (og + 1u == (tg + 1u) * nx) xb_add(&bar[XB_TOPGEN], 1u);
            else XB_SPIN(xb_ld(&bar[XB_TOPGEN]) == tg, bar);
            __builtin_amdgcn_fence(__ATOMIC_ACQUIRE, "agent");
            xb_add(&bar[XB_XGEN(b.x)], 1u);
            asm volatile("s_waitcnt vmcnt(0)" ::: "memory");
        } else {
            XB_SPIN(xb_ld(&bar[XB_XGEN(b.x)]) == gen, bar);
            __builtin_amdgcn_fence(__ATOMIC_ACQUIRE, "agent");
            asm volatile("s_waitcnt vmcnt(0)" ::: "memory");
        }
    }
    __syncthreads();
}

constexpr int N_PHASES = 35;
__device__ __forceinline__ void run_phase(const Params& p, unsigned char* lds, int ph) {
    if (ph == 0) { phase_prep(p, lds); return; }
    const int q = ph - 1; int layer, k;
    if (q < 8) { layer = 0; k = q; } else if (q < 17) { layer = 1; k = q - 8; } else if (q < 25) { layer = 2; k = q - 17; } else { layer = 3; k = q - 25; }
    const int idx = layer >> 1;
    if ((layer & 1) == 0) {
        if (k == 0) phase_gemm(p, lds, layer, 0);
        else if (k == 1) { if (!(DBG_SKIP & 1)) phase_even_mix(p, lds, idx); if (DBG_REP & 1) { __syncthreads(); phase_even_mix(p, lds, idx); } }
        else if (k == 2) { if (!(DBG_SKIP & 1)) phase_hgrn_fin(p, idx); }
        else if (k == 3) phase_gemm(p, lds, layer, 1);
        else if (k == 4) phase_rowpass(p, layer, 0);
        else if (k == 5) phase_gemm(p, lds, layer, 2);
        else if (k == 6) phase_gemm(p, lds, layer, 3);
        else phase_rowpass(p, layer, 1);
    } else {
        if (k == 0) phase_gemm(p, lds, layer, 0);
        else if (k == 1) { if (!(DBG_SKIP & 2)) phase_odd_mix1(p, lds, idx); if (DBG_REP & 2) { __syncthreads(); phase_odd_mix1(p, lds, idx); } }
        else if (k == 2) { if (!(DBG_SKIP & 2)) phase_rg_carry(p); }
        else if (k == 3) { if (!(DBG_SKIP & 2)) phase_odd_mix3(p, lds, idx); if (DBG_REP & 4) { __syncthreads(); phase_odd_mix3(p, lds, idx); } }
        else if (k == 4) phase_gemm(p, lds, layer, 1);
        else if (k == 5) phase_rowpass(p, layer, 0);
        else if (k == 6) phase_gemm(p, lds, layer, 2);
        else if (k == 7) phase_gemm(p, lds, layer, 3);
        else phase_rowpass(p, layer, 1);
    }
}

__global__ void __launch_bounds__(512, 2) fwd_kernel(Params p) {
    extern __shared__ __attribute__((aligned(16))) unsigned char lds[];
    cg::grid_group grid = cg::this_grid();
    volatile LAS unsigned* st = (volatile LAS unsigned*)(lds + LDS_BYTES - 16);
    if (threadIdx.x < 4) st[threadIdx.x] = 0u;
    __syncthreads();
    const XcdBarrier bar = xcd_barrier_post((unsigned*)(p.ws + WS_CTL) + 256, st);
    for (int ph = p.ph_lo; ph < p.ph_hi; ++ph) {
        if (ph == p.ph_lo + 1) grid.sync();
        else if (ph > p.ph_lo) xcd_barrier(bar);
        run_phase(p, lds, ph);
    }
}

extern "C" void kernel_launch(void* const* d_in, const int* in_sizes, int n_in, void* d_out, int out_size, void* d_ws, size_t ws_size, hipStream_t stream) {
    static int grid = 0;
    if (grid == 0) {
        if (n_in != 21 || ws_size < WS_RS + (size_t)NTOK * 4) { fprintf(stderr, "kernel_launch: unexpected n_in %d / ws_size %zu (need %zu)\n", n_in, ws_size, (size_t)WS_END); grid = -1; return; }
        int dev = 0, cus = 0, per_cu = 0;
        (void)hipGetDevice(&dev); (void)hipDeviceGetAttribute(&cus, hipDeviceAttributeMultiprocessorCount, dev);
        if (hipFuncSetAttribute((const void*)fwd_kernel, hipFuncAttributeMaxDynamicSharedMemorySize, LDS_BYTES) != hipSuccess) { fprintf(stderr, "kernel_launch: hipFuncSetAttribute failed\n"); grid = -1; return; }
        if (hipOccupancyMaxActiveBlocksPerMultiprocessor(&per_cu, (const void*)fwd_kernel, NTHR, LDS_BYTES) != hipSuccess || per_cu < 1) { fprintf(stderr, "kernel_launch: occupancy query says %d\n", per_cu); per_cu = 1; }
        (void)hipGetLastError();
        grid = cus > 0 ? cus : 256;
    }
    if (grid < 0) return;
    if (hipMemsetAsync((char*)d_ws + WS_CTL, 0, CTL_BYTES, stream) != hipSuccess) { fprintf(stderr, "kernel_launch: memset of the control words failed\n"); return; }
    Params p{};
    for (int i = 0; i < 21; ++i) p.in[i] = (const float*)d_in[i];
    p.out = (float*)d_out; p.ws = (unsigned char*)d_ws;
#if MK_MULTI_LAUNCH
    for (int ph = 0; ph < N_PHASES; ++ph) { p.ph_lo = ph; p.ph_hi = ph + 1; hipLaunchKernelGGL(fwd_kernel, dim3(grid), dim3(NTHR), LDS_BYTES, stream, p); }
#else
    p.ph_lo = 0; p.ph_hi = N_PHASES;
    void* args[] = {&p};
    hipError_t e = hipLaunchCooperativeKernel((const void*)fwd_kernel, dim3(grid), dim3(NTHR), args, LDS_BYTES, stream);
    if (e != hipSuccess) fprintf(stderr, "kernel_launch: cooperative launch failed: %s (grid %d)\n", hipGetErrorString(e), grid);
#endif
}
```
